# Optimizing an MI355X kernel written in HIP

```python
import math
import jax, jax.numpy as jnp
from jax import lax
import numpy as np


D_MODEL = 2048
BATCH = 1
SEQ = 16384
DEPTH = 4
DEC_BATCH = 16
DEC_SEQ = 16
PAST_LEN = 4096

CHUNK = 64
N_MIXERS = 3
N_HGRN = len(range(0, DEPTH, N_MIXERS))
N_POOL = len(range(1, DEPTH, N_MIXERS))
N_ATTN = len(range(2, DEPTH, N_MIXERS))
HG_EXPAND = 128
HG_HEADS = D_MODEL // HG_EXPAND
HG_DK = HG_EXPAND
HG_FD = HG_HEADS * HG_DK
HG_DV = D_MODEL // HG_HEADS
F_MIN = 1e-6
POOL_WINDOWS = (2, 4, 8, 16)
POOL_GROUPS = len(POOL_WINDOWS)
POOL_GC = D_MODEL // POOL_GROUPS
POOL_HIST = max(POOL_WINDOWS) - 1
DA_HEADS = 8
DA_DH = D_MODEL // (2 * DA_HEADS)
Q_BLOCK = 128
REL_BUCKETS = 32
REL_MAX_DIST = 128
MASK_VALUE = -1e30
D_FF = ((8 * D_MODEL // 3 + 255) // 256) * 256
EPS = 1e-6

kernel_name = 'hybrid_stream_hgrn2_pool_diffattn'


def rmsnorm(x, g):
    xf = x.astype(jnp.float32)
    y = xf * lax.rsqrt(jnp.mean(xf * xf, axis=-1, keepdims=True) + EPS) * g.astype(jnp.float32)
    return y.astype(x.dtype)


def swiglu(x, w_gate, w_up, w_down):
    return (jax.nn.silu(x @ w_gate) * (x @ w_up)) @ w_down


def hgrn2_recurrence(q, k, v, logf, S0):
    B, T, H, DK = q.shape
    DV = v.shape[-1]
    C = min(CHUNK, T)
    n = T // C
    def to_chunks(a):
        return a.astype(jnp.float32).reshape(B, n, C, H, a.shape[-1]).transpose(1, 0, 3, 2, 4)
    qc, kc, vc, gc = to_chunks(q), to_chunks(k), to_chunks(v), to_chunks(logf)
    causal = jnp.tril(jnp.ones((C, C), dtype=bool))[:, :, None]
    causal_f = causal.astype(jnp.float32)
    def step(S, inp):
        qi, ki, vi, gi = inp
        G = jnp.cumsum(gi, axis=2)
        inter = jnp.einsum('bhtk,bhkv->bhtv', qi * jnp.exp(G), S)
        diff = G[:, :, :, None, :] - G[:, :, None, :, :]
        decay = jnp.exp(jnp.where(causal, diff, 0.0)) * causal_f
        scores = jnp.einsum('bhtk,bhsk,bhtsk->bhts', qi, ki, decay)
        intra = jnp.einsum('bhts,bhsv->bhtv', scores, vi)
        G_last = G[:, :, -1]
        k_dec = ki * jnp.exp(G_last[:, :, None, :] - G)
        S_new = jnp.exp(G_last)[..., None] * S + jnp.einsum('bhsk,bhsv->bhkv', k_dec, vi)
        return S_new, inter + intra
    S_T, o = lax.scan(step, S0.astype(jnp.float32), (qc, kc, vc, gc))
    o = o.transpose(1, 0, 3, 2, 4).reshape(B, T, H, DV)
    return o, S_T


def hgrn2_mixer(xn, S0, w_q, w_f, w_i, w_g, w_o, lb, gain):
    B, T, D = xn.shape
    q = (xn @ w_q).reshape(B, T, HG_HEADS, HG_DK)
    f_pre = (xn @ w_f).reshape(B, T, HG_HEADS, HG_DK).astype(jnp.float32)
    lbh = lb.reshape(HG_HEADS, HG_DK)
    f = lbh + (1.0 - lbh) * jax.nn.sigmoid(f_pre)
    logf = jnp.log(jnp.maximum(f, F_MIN))
    k = 1.0 - f
    v = (xn @ w_i).reshape(B, T, HG_HEADS, HG_DV)
    o, S_T = hgrn2_recurrence(q, k, v, logf, S0)
    o = rmsnorm(o.astype(xn.dtype), gain).reshape(B, T, D) * jax.nn.silu(xn @ w_g)
    return o @ w_o, S_T


def pool_mixer(xn, hist, pos0, w_grp, scale):
    B, T, D = xn.shape
    P = POOL_HIST
    xa = jnp.concatenate([hist.astype(xn.dtype), xn], axis=1)
    xf = xa.astype(jnp.float32)
    cs = jnp.concatenate([jnp.zeros((B, 1, D), jnp.float32), jnp.cumsum(xf, axis=1)], axis=1)
    pos = pos0 + jnp.arange(T)
    xt = xf[:, P:]
    pooled = []
    for g, w in enumerate(POOL_WINDOWS):
        sl = slice(g * POOL_GC, (g + 1) * POOL_GC)
        wsum = cs[:, P + 1:P + 1 + T, sl] - cs[:, P + 1 - w:P + 1 - w + T, sl]
        cnt = jnp.minimum(w, pos + 1).astype(jnp.float32)[None, :, None]
        pooled.append(wsum / cnt - xt[:, :, sl])
    pooled = jnp.stack(pooled, axis=2).astype(xn.dtype)
    out = jnp.einsum('btgc,gce->btge', pooled, w_grp).reshape(B, T, D) * scale
    return out, xa[:, -P:]


def rel_bucket(rel):
    nb = REL_BUCKETS // 2
    max_exact = nb // 2
    n = jnp.abs(rel)
    large = max_exact + (jnp.log(jnp.maximum(n, max_exact).astype(jnp.float32) / max_exact)
                         / math.log(REL_MAX_DIST / max_exact) * (nb - max_exact)).astype(jnp.int32)
    large = jnp.minimum(large, nb - 1)
    return jnp.where(rel > 0, nb, 0) + jnp.where(n < max_exact, n, large)


def diff_attention_core(q, k, v, q_pos, lam, rel_table):
    B, Tq, H, _, dh = q.shape
    Tk = k.shape[1]
    QB = min(Q_BLOCK, Tq)
    nb = Tq // QB
    k_pos = jnp.arange(Tk)
    qb = q.reshape(B, nb, QB, H, 2, dh).transpose(1, 0, 2, 3, 4, 5)
    pb = q_pos.reshape(nb, QB)
    scale = dh ** -0.5
    def block(args):
        qi, pi = args
        s = jnp.einsum('bqhcd,bkhcd->bhcqk', qi, k).astype(jnp.float32) * scale
        bias = rel_table.astype(jnp.float32)[rel_bucket(k_pos[None, :] - pi[:, None])]
        s = s + bias.transpose(2, 0, 1)[None, :, None]
        mask = (k_pos[None, :] // CHUNK) <= (pi[:, None] // CHUNK)
        s = jnp.where(mask, s, MASK_VALUE)
        p = jax.nn.softmax(s, axis=-1)
        a = p[:, :, 0] - lam * p[:, :, 1]
        return jnp.einsum('bhqk,bkhe->bqhe', a.astype(v.dtype), v)
    o = lax.map(block, (qb, pb))
    return o.transpose(1, 0, 2, 3, 4).reshape(B, Tq, H, 2 * dh)


def diff_attn_mixer(xn, k_past, v_past, q_pos, w_q, w_k, w_v, w_o, lq1, lk1, lq2, lk2,
                    sub_gain, rel_table, lambda_init):
    B, T, D = xn.shape
    q = (xn @ w_q).reshape(B, T, DA_HEADS, 2, DA_DH)
    k_new = (xn @ w_k).reshape(B, T, 2 * DA_HEADS, DA_DH)
    v_new = (xn @ w_v).reshape(B, T, DA_HEADS, 2 * DA_DH)
    if k_past is None:
        k_all, v_all = k_new, v_new
    else:
        k_all = jnp.concatenate([k_past.astype(k_new.dtype), k_new], axis=1)
        v_all = jnp.concatenate([v_past.astype(v_new.dtype), v_new], axis=1)
    Tk = k_all.shape[1]
    lam = (jnp.exp(jnp.sum(lq1.astype(jnp.float32) * lk1.astype(jnp.float32)))
           - jnp.exp(jnp.sum(lq2.astype(jnp.float32) * lk2.astype(jnp.float32))) + lambda_init)
    o = diff_attention_core(q, k_all.reshape(B, Tk, DA_HEADS, 2, DA_DH), v_all, q_pos, lam, rel_table)
    o = rmsnorm(o, sub_gain) * (1.0 - lambda_init)
    return o.reshape(B, T, D) @ w_o, k_new, v_new


def setup_inputs(seed: int = 0) -> dict:
    key = jax.random.key(seed)
    ks = iter(jax.random.split(key, 40))
    def nrm(shape, s=1.0):
        return s * jax.random.normal(next(ks), shape, jnp.float32)
    D = D_MODEL
    return {
        'x_prompt': nrm((BATCH, SEQ, D)),
        'x_sample': nrm((DEC_BATCH, DEC_SEQ, D)),
        'state_hgrn': nrm((N_HGRN, DEC_BATCH, HG_HEADS, HG_DK, HG_DV), 0.5),
        'state_pool': nrm((N_POOL, DEC_BATCH, POOL_HIST, D)),
        'cache_k': nrm((N_ATTN, DEC_BATCH, PAST_LEN, 2 * DA_HEADS, DA_DH)),
        'cache_v': nrm((N_ATTN, DEC_BATCH, PAST_LEN, DA_HEADS, 2 * DA_DH)),
        'norm_mix': 1.0 + nrm((DEPTH, D), 0.02),
        'norm_ffn': 1.0 + nrm((DEPTH, D), 0.02),
        'norm_final': 1.0 + nrm((D,), 0.02),
        'hgrn_w_q': nrm((N_HGRN, D, HG_FD), D ** -0.5),
        'hgrn_w_f': nrm((N_HGRN, D, HG_FD), D ** -0.5),
        'hgrn_w_i': nrm((N_HGRN, D, D), D ** -0.5),
        'hgrn_w_g': nrm((N_HGRN, D, D), D ** -0.5),
        'hgrn_w_o': nrm((N_HGRN, D, D), D ** -0.5),
        'hgrn_lb_logits': nrm((N_HGRN, HG_FD), 0.5),
        'hgrn_norm_gain': 1.0 + nrm((N_HGRN, HG_DV), 0.02),
        'pool_w': nrm((N_POOL, POOL_GROUPS, POOL_GC, POOL_GC), POOL_GC ** -0.5),
        'pool_scale': 1.0 + nrm((N_POOL, D), 0.1),
        'attn_w_q': nrm((N_ATTN, D, 2 * DA_HEADS * DA_DH), D ** -0.5),
        'attn_w_k': nrm((N_ATTN, D, 2 * DA_HEADS * DA_DH), D ** -0.5),
        'attn_w_v': nrm((N_ATTN, D, 2 * DA_HEADS * DA_DH), D ** -0.5),
        'attn_w_o': nrm((N_ATTN, 2 * DA_HEADS * DA_DH, D), D ** -0.5),
        'attn_lambda_q1': nrm((N_ATTN, DA_DH), 0.1),
        'attn_lambda_k1': nrm((N_ATTN, DA_DH), 0.1),
        'attn_lambda_q2': nrm((N_ATTN, DA_DH), 0.1),
        'attn_lambda_k2': nrm((N_ATTN, DA_DH), 0.1),
        'attn_subln_gain': 1.0 + nrm((N_ATTN, 2 * DA_DH), 0.02),
        'rel_bias_table': nrm((REL_BUCKETS, DA_HEADS), 0.5),
        'ffn_w_gate': nrm((DEPTH, D, D_FF), D ** -0.5),
        'ffn_w_up': nrm((DEPTH, D, D_FF), D ** -0.5),
        'ffn_w_down': nrm((DEPTH, D_FF, D), D_FF ** -0.5),
    }


def reference(x_prompt, x_sample, state_hgrn, state_pool, cache_k, cache_v,
              norm_mix, norm_ffn, norm_final,
              hgrn_w_q, hgrn_w_f, hgrn_w_i, hgrn_w_g, hgrn_w_o, hgrn_lb_logits, hgrn_norm_gain,
              pool_w, pool_scale,
              attn_w_q, attn_w_k, attn_w_v, attn_w_o,
              attn_lambda_q1, attn_lambda_k1, attn_lambda_q2, attn_lambda_k2, attn_subln_gain,
              rel_bias_table, ffn_w_gate, ffn_w_up, ffn_w_down):
    B, T = x_prompt.shape[0], x_prompt.shape[1]
    Ts = x_sample.shape[1]
    p_lb = jax.nn.softmax(hgrn_lb_logits.astype(jnp.float32), axis=0)
    lower_bounds = jnp.maximum(jnp.cumsum(p_lb, axis=0) - p_lb[0], 0.0)
    pos_p = jnp.arange(T)
    pos_s = PAST_LEN + jnp.arange(Ts)
    x_p, x_s = x_prompt, x_sample
    hg_p, hg_s, pl_p, pl_s, k_p, v_p, k_s, v_s = [], [], [], [], [], [], [], []
    for i in range(DEPTH):
        m, j = i % N_MIXERS, i // N_MIXERS
        xn_p = rmsnorm(x_p, norm_mix[i])
        xn_s = rmsnorm(x_s, norm_mix[i])
        if m == 0:
            w = (hgrn_w_q[j], hgrn_w_f[j], hgrn_w_i[j], hgrn_w_g[j], hgrn_w_o[j],
                 lower_bounds[j], hgrn_norm_gain[j])
            o_p, S_p = hgrn2_mixer(xn_p, jnp.zeros((B, HG_HEADS, HG_DK, HG_DV), jnp.float32), *w)
            o_s, S_s = hgrn2_mixer(xn_s, state_hgrn[j], *w)
            hg_p.append(S_p.astype(x_prompt.dtype))
            hg_s.append(S_s.astype(state_hgrn.dtype))
        elif m == 1:
            o_p, P_p = pool_mixer(xn_p, jnp.zeros((B, POOL_HIST, D_MODEL), xn_p.dtype), 0,
                                  pool_w[j], pool_scale[j])
            o_s, P_s = pool_mixer(xn_s, state_pool[j], PAST_LEN, pool_w[j], pool_scale[j])
            pl_p.append(P_p)
            pl_s.append(P_s)
        else:
            lambda_init = 0.8 - 0.6 * math.exp(-0.3 * i)
            w = (attn_w_q[j], attn_w_k[j], attn_w_v[j], attn_w_o[j],
                 attn_lambda_q1[j], attn_lambda_k1[j], attn_lambda_q2[j], attn_lambda_k2[j],
                 attn_subln_gain[j], rel_bias_table, lambda_init)
            o_p, kn_p, vn_p = diff_attn_mixer(xn_p, None, None, pos_p, *w)
            o_s, kn_s, vn_s = diff_attn_mixer(xn_s, cache_k[j], cache_v[j], pos_s, *w)
            k_p.append(kn_p)
            v_p.append(vn_p)
            k_s.append(kn_s)
            v_s.append(vn_s)
        x_p = x_p + o_p
        x_s = x_s + o_s
        x_p = x_p + swiglu(rmsnorm(x_p, norm_ffn[i]), ffn_w_gate[i], ffn_w_up[i], ffn_w_down[i])
        x_s = x_s + swiglu(rmsnorm(x_s, norm_ffn[i]), ffn_w_gate[i], ffn_w_up[i], ffn_w_down[i])
    y_prompt = rmsnorm(x_p, norm_final)
    y_sample = rmsnorm(x_s, norm_final)
    new_hgrn_prompt = jnp.stack(hg_p)
    new_hgrn_sample = jnp.stack(hg_s)
    new_pool_prompt = jnp.stack(pl_p)
    new_pool_sample = jnp.stack(pl_s)
    new_k_prompt = jnp.stack(k_p)
    new_v_prompt = jnp.stack(v_p)
    new_k_sample = jnp.stack(k_s)
    new_v_sample = jnp.stack(v_s)
    return (y_prompt, y_sample, new_hgrn_prompt, new_hgrn_sample, new_pool_prompt, new_pool_sample,
            new_k_prompt, new_v_prompt, new_k_sample, new_v_sample)
```

```cpp
#include <hip/hip_runtime.h>
#include <cstdio>
#include <cstdint>

#ifndef MK_ONE_LAUNCH
#define MK_ONE_LAUNCH 1
#endif

#define LAS __attribute__((address_space(3)))
#define GAS __attribute__((address_space(1)))
typedef unsigned short bf16;
typedef short bf16x8 __attribute__((ext_vector_type(8)));
typedef short s16x4 __attribute__((ext_vector_type(4)));
typedef float f32x4 __attribute__((ext_vector_type(4)));
typedef float f32x2 __attribute__((ext_vector_type(2)));
typedef float f32x8 __attribute__((ext_vector_type(8)));
typedef float f32x16 __attribute__((ext_vector_type(16)));
typedef unsigned u32x4 __attribute__((ext_vector_type(4)));
typedef unsigned u32x2 __attribute__((ext_vector_type(2)));

constexpr int D = 2048, MP = 16384, MS = 256, M = MP + MS, FF = 5632, NHG = 8192, NQKV = 6144;
constexpr float EPS = 1e-6f;
constexpr float LAMBDA_INIT = 0.4707130183435842f;
constexpr float ATT_SCALE = 0.088388347648318440f;
constexpr size_t OFF_Y_P = 0, OFF_Y_S = 33554432, OFF_HG_P = 34078720, OFF_HG_S = 34603008, OFF_PL_P = 42991616, OFF_PL_S = 43022336,
                 OFF_K_P = 43513856, OFF_V_P = 77068288, OFF_K_S = 110622720, OFF_V_S = 111147008, OUT_END = 111671296;
constexpr size_t MiB = 1u << 20;
constexpr size_t WS_CTL = 0, CTL_ZERO_BYTES = 64 * 1024;
constexpr size_t WS_CONST = 2 * MiB;
constexpr size_t WS_HG0 = 4 * MiB, HG_STRIDE = 40 * MiB;
constexpr size_t WS_QKV = 84 * MiB, WS_WOA = 108 * MiB, WS_WP = 116 * MiB;
constexpr size_t WS_W1 = 118 * MiB, FFN_STRIDE = 66 * MiB, W2_OFF = 44 * MiB;
constexpr size_t WS_X = 384 * MiB;
constexpr size_t WS_XB = 514 * MiB;
constexpr size_t WS_A0 = 580 * MiB;
constexpr size_t WS_A1 = 645 * MiB;
constexpr size_t WS_A2 = 775 * MiB;
constexpr size_t WS_A3 = 840 * MiB;
constexpr size_t WS_A4 = 905 * MiB;
constexpr size_t WS_SB = 970 * MiB;
constexpr size_t WS_DT = 1034 * MiB;
constexpr size_t WS_PART = 1036 * MiB;
constexpr size_t WS_SSQ = 1048 * MiB;
constexpr size_t WS_SSQS = 1054 * MiB;
constexpr size_t WS_END = 1056 * MiB;
constexpr int CW_TMO = 0, CW_BAR = 4096;
constexpr int LDS_BYTES = 147456, MISC_OFF = 131072 + 8192 + 2048 + 320;

__device__ __forceinline__ unsigned cvt_pk_bf16(float lo, float hi) { unsigned r; asm volatile("v_cvt_pk_bf16_f32 %0, %1, %2" : "=v"(r) : "v"(lo), "v"(hi)); return r; }
__device__ __forceinline__ float bf2f(unsigned short b) { return __uint_as_float(((unsigned)b) << 16); }
typedef _Float16 f16x2 __attribute__((ext_vector_type(2)));
__device__ __forceinline__ unsigned pk_f16(float a, float b) { f16x2 v; v.x = (_Float16)a; v.y = (_Float16)b; return __builtin_bit_cast(unsigned, v); }
__device__ __forceinline__ float h2f(unsigned short u) { return (float)__builtin_bit_cast(_Float16, u); }
__device__ __forceinline__ float wave_sum(float v) {
#pragma unroll
    for (int o = 1; o < 64; o <<= 1) v += __shfl_xor(v, o);
    return v;
}
__device__ __forceinline__ int opaque_tid() { int t = threadIdx.x; asm volatile("" : "+v"(t)); return t; }
__device__ __forceinline__ float row16_sum(float v) {
    v += __builtin_bit_cast(float, __builtin_amdgcn_update_dpp(0, __builtin_bit_cast(int, v), 0x128, 0xf, 0xf, false));
    v += __builtin_bit_cast(float, __builtin_amdgcn_update_dpp(0, __builtin_bit_cast(int, v), 0x124, 0xf, 0xf, false));
    v += __builtin_bit_cast(float, __builtin_amdgcn_update_dpp(0, __builtin_bit_cast(int, v), 0x122, 0xf, 0xf, false));
    v += __builtin_bit_cast(float, __builtin_amdgcn_update_dpp(0, __builtin_bit_cast(int, v), 0x121, 0xf, 0xf, false));
    return v;
}
__device__ __forceinline__ float fast_exp(float x) { return __builtin_amdgcn_exp2f(x * 1.4426950408889634f); }
__device__ __forceinline__ float sigmoidf_(float x) { return __builtin_amdgcn_rcpf(1.0f + fast_exp(-x)); }
__device__ __forceinline__ void sigmoid8(const float (&x)[8], float (&sg)[8]) {
    float e[8];
#define SG8_PIN() asm volatile("" : "+v"(e[0]), "+v"(e[1]), "+v"(e[2]), "+v"(e[3]), "+v"(e[4]), "+v"(e[5]), "+v"(e[6]), "+v"(e[7]))
#pragma unroll
    for (int j = 0; j < 8; ++j) e[j] = x[j] * -1.4426950408889634f;
    SG8_PIN();
#pragma unroll
    for (int j = 0; j < 8; ++j) e[j] = __builtin_amdgcn_exp2f(e[j]);
    SG8_PIN();
#pragma unroll
    for (int j = 0; j < 8; ++j) e[j] = 1.0f + e[j];
    SG8_PIN();
#pragma unroll
    for (int j = 0; j < 8; ++j) e[j] = __builtin_amdgcn_rcpf(e[j]);
    SG8_PIN();
#pragma unroll
    for (int j = 0; j < 8; ++j) sg[j] = e[j];
#undef SG8_PIN
}
#define LDS_WAIT() asm volatile("s_waitcnt lgkmcnt(0)" ::: "memory")
#define VM_WAIT() asm volatile("s_waitcnt vmcnt(0)" ::: "memory")

namespace pg8 {
#define PG8_LAS __attribute__((address_space(3)))
typedef unsigned short bf16_t;
constexpr int BM = 256, BK = 64, HALF = 128, HTB = HALF * BK * 2, STAGE_BYTES = 8 * HTB, NXCD = 8, WGM = 4;
__host__ __device__ __forceinline__ int lds_byte(int r, int c) { const int st = (r >> 4) * 2 + (c >> 5), rr = r & 15, cc = c & 31, ob = rr * 64 + cc * 2; return st * 1024 + (ob ^ (((ob >> 9) & 1) << 5)); }
__host__ __device__ __forceinline__ void stage_rc(int b, int& R, int& C) { const int st = b / 1024, sb = b % 1024, swz = sb ^ (((sb >> 9) & 1) << 5); R = (st >> 1) * 16 + swz / 64; C = (st & 1) * 32 + (swz % 64) / 2; }
__host__ __device__ __forceinline__ int perm32(int rho) { const int n = rho >> 4, i = rho & 15; return 8 * (i >> 2) + 4 * n + (i & 3); }
struct Unit { int pm, pn; };
struct Gemm { const bf16_t* A; const bf16_t* Bt; int M, N, K, lda, ldb, a_koff; };
struct StaticOrder {
    int nM, nN, nwg, G, c, rev;
    __host__ __device__ void init(int M_, int N_, int G_, int c_, int rev_ = 0) { nM = M_ / BM; nN = N_ / BM; nwg = nM * nN; G = G_; c = c_; rev = rev_; }
    __host__ __device__ bool next(int i, Unit& u) const {
        const long L = (long)i * G + c; if (L >= nwg) return false;
        int wgid = (int)L; { const int q = nwg / NXCD, r = nwg % NXCD, xcd = wgid % NXCD, off = wgid / NXCD; wgid = (xcd < r ? xcd * (q + 1) : r * (q + 1) + (xcd - r) * q) + off; }
        const int nig = WGM * nN, gid = wgid / nig, fm = gid * WGM, gsz = (nM - fm) < WGM ? (nM - fm) : WGM;
        u.pm = fm + ((wgid % nig) % gsz); u.pn = (wgid % nig) / gsz; if (rev) u.pm = nM - 1 - u.pm; return true;
    }
    __device__ __forceinline__ void a_ready(const Unit&) const {}
    __device__ __forceinline__ void done(const Unit&) const {}
};

__device__ __forceinline__ float row_scale(const float* ssq, int row);
template <class Epi, class Sched, bool ALIGN_EPI = false, bool SP2 = false>
__device__ __forceinline__ void gemm_phase(PG8_LAS unsigned char* lds, const Gemm g, const Sched& S, const Epi& E) {
    const int tid = opaque_tid(), wid = __builtin_amdgcn_readfirstlane(tid >> 6), lane = tid & 63, wr = wid >> 2, wc = wid & 3, fr = lane & 15, fq = lane >> 4;
    const int K = g.K, nt = K / BK;
    unsigned voffA[2], voffB[2];
#pragma unroll
    for (int i = 0; i < 2; ++i) { int R, C; stage_rc(tid * 16 + i * 8192, R, C); const int Rb = Epi::PERM ? ((R & ~31) + perm32(R & 31)) : R;
        voffA[i] = (unsigned)(R * g.lda + C) * 2u; voffB[i] = (unsigned)(Rb * g.ldb + C) * 2u; }
    const size_t kstep = (size_t)(BK * 2);
    const size_t hstepA = (size_t)HALF * g.lda * 2, hstepB = (size_t)HALF * g.ldb * 2;
    const size_t tstepA = 2 * hstepA, tstepB = 2 * hstepB;
    const unsigned ldsw = (unsigned)wid * 1024u;
    const int aoff = lds_byte(wr * 64 + fr, fq * 8), boff = lds_byte(wc * 32 + fr, fq * 8);
#define PG8_SA(b, h) (((b) * 2 + (h)) * HTB)
#define PG8_SB(b, h) ((4 + (b) * 2 + (h)) * HTB)
#define PG8_STAGE(bufoff, gbase, voff) do { _Pragma("unroll") for (int _i = 0; _i < 2; ++_i) \
        __builtin_amdgcn_global_load_lds((const unsigned*)((const char*)(gbase) + (voff)[_i]), (PG8_LAS unsigned*)(lds + (bufoff) + ldsw + _i * 8192), 16, 0, 0); } while (0)
#define PG8_LDA(dst, b, h) do { _Pragma("unroll") for (int m = 0; m < 4; ++m) _Pragma("unroll") for (int k = 0; k < 2; ++k) dst[m][k] = *(const PG8_LAS bf16x8*)(lds + PG8_SA(b, h) + aoff + m * 2048 + k * 1024); } while (0)
#define PG8_LDB(dst, b, h) do { _Pragma("unroll") for (int n = 0; n < 2; ++n) _Pragma("unroll") for (int k = 0; k < 2; ++k) dst[n][k] = *(const PG8_LAS bf16x8*)(lds + PG8_SB(b, h) + boff + n * 2048 + k * 1024); } while (0)
#define PG8_MMA(ai, bj, At, Bt) do { __builtin_amdgcn_s_setprio(1); _Pragma("unroll") for (int m = 0; m < 4; ++m) _Pragma("unroll") for (int n = 0; n < 2; ++n) _Pragma("unroll") for (int k = 0; k < 2; ++k) \
        acc[ai][bj][m][n] = __builtin_amdgcn_mfma_f32_16x16x32_bf16(Bt[n][k], At[m][k], acc[ai][bj][m][n], 0, 0, 0); __builtin_amdgcn_s_setprio(0); } while (0)
#define PG8_WAIT_V(n) asm volatile("s_waitcnt vmcnt(" #n ")" ::: "memory")
#define PG8_WAIT_L(n) asm volatile("s_waitcnt lgkmcnt(" #n ")" ::: "memory")
#define PG8_BAR __builtin_amdgcn_s_barrier()
#define PG8_SCHED __builtin_amdgcn_sched_barrier(0)
#define PG8_UA(u) ((const char*)g.A + (size_t)(u).pm * tstepA + (size_t)((u).pn >> 1) * (size_t)g.a_koff * 2)
#define PG8_UB(u) ((const char*)g.Bt + (size_t)(u).pn * tstepB)
    Unit cur, nxt; int ui = 0;
    if (!S.next(0, cur)) return;
    f32x4 acc[2][2][4][2];
#pragma unroll
    for (int a = 0; a < 2; ++a)
#pragma unroll
        for (int b = 0; b < 2; ++b)
#pragma unroll
            for (int m = 0; m < 4; ++m)
#pragma unroll
                for (int n = 0; n < 2; ++n) acc[a][b][m][n] = (f32x4){0.f, 0.f, 0.f, 0.f};
    bf16x8 At[4][2], B0[2][2], B1[2][2];
    const char* cA = PG8_UA(cur); const char* cB = PG8_UB(cur);
    S.a_ready(cur);
    float rsv[2][4];
#define PG8_RS(u_) do { if constexpr (Epi::NEEDS_RS) { _Pragma("unroll") for (int ai_ = 0; ai_ < 2; ++ai_) _Pragma("unroll") for (int m_ = 0; m_ < 4; ++m_) rsv[ai_][m_] = row_scale(E.ssq, (u_).pm * BM + wr * 64 + fr + ai_ * HALF + m_ * 16); } } while (0)
    PG8_RS(cur);
    if constexpr (SP2) {
        PG8_STAGE(PG8_SB(0, 0), cB, voffB); PG8_STAGE(PG8_SB(0, 1), cB + hstepB, voffB); PG8_STAGE(PG8_SA(0, 0), cA, voffA); PG8_STAGE(PG8_SA(0, 1), cA + hstepA, voffA);
        if (wr == 1) PG8_BAR;
        PG8_WAIT_V(2); PG8_BAR;
        PG8_STAGE(PG8_SB(1, 0), cB + kstep, voffB); PG8_STAGE(PG8_SA(1, 0), cA + kstep, voffA); PG8_STAGE(PG8_SB(1, 1), cB + hstepB + kstep, voffB);
        PG8_WAIT_V(6); PG8_BAR;
    } else {
        PG8_STAGE(PG8_SB(0, 0), cB, voffB); PG8_STAGE(PG8_SA(0, 0), cA, voffA); PG8_STAGE(PG8_SB(0, 1), cB + hstepB, voffB); PG8_STAGE(PG8_SA(0, 1), cA + hstepA, voffA);
        if (wr == 1) PG8_BAR;
        PG8_WAIT_V(4); PG8_BAR;
        PG8_STAGE(PG8_SB(1, 0), cB + kstep, voffB); PG8_STAGE(PG8_SA(1, 0), cA + kstep, voffA); PG8_STAGE(PG8_SB(1, 1), cB + hstepB + kstep, voffB);
        PG8_WAIT_V(6); PG8_BAR;
    }
    for (;;) {
        const bool has_next = S.next(ui + 1, nxt);
        const char* nA = has_next ? PG8_UA(nxt) : cA; const char* nB = has_next ? PG8_UB(nxt) : cB;
        for (int t = 0; t < nt; t += 2) {
            const bool last = (t == nt - 2);
            const char* a1 = cA + (size_t)(t + 1) * kstep;
            const char* a2 = last ? nA : cA + (size_t)(t + 2) * kstep; const char* b2 = last ? nB : cB + (size_t)(t + 2) * kstep;
            const char* a3 = a2 + kstep; const char* b3 = b2 + kstep;
            if (last && has_next) S.a_ready(nxt);
            if constexpr (SP2) {
            PG8_LDB(B0, 0, 0); PG8_LDB(B1, 0, 1); PG8_SCHED; PG8_LDA(At, 0, 0); PG8_STAGE(PG8_SA(1, 1), a1 + hstepA, voffA);
            PG8_WAIT_V(8); PG8_WAIT_L(0); PG8_BAR; PG8_MMA(0, 0, At, B0); PG8_MMA(0, 1, At, B1); PG8_BAR; PG8_SCHED;
            PG8_LDA(At, 0, 1); PG8_STAGE(PG8_SB(0, 0), b2, voffB); PG8_STAGE(PG8_SB(0, 1), b2 + hstepB, voffB); PG8_STAGE(PG8_SA(0, 0), a2, voffA);
            PG8_WAIT_V(8); PG8_WAIT_L(0); PG8_BAR; PG8_MMA(1, 0, At, B0); PG8_MMA(1, 1, At, B1); PG8_BAR; PG8_SCHED;
            PG8_LDB(B0, 1, 0); PG8_LDB(B1, 1, 1); PG8_SCHED; PG8_LDA(At, 1, 0); PG8_STAGE(PG8_SA(0, 1), a2 + hstepA, voffA);
            PG8_WAIT_V(8); PG8_WAIT_L(0); PG8_BAR; PG8_MMA(0, 0, At, B0); PG8_MMA(0, 1, At, B1); PG8_BAR; PG8_SCHED;
            PG8_LDA(At, 1, 1); PG8_STAGE(PG8_SB(1, 0), b3, voffB); PG8_STAGE(PG8_SB(1, 1), b3 + hstepB, voffB); PG8_STAGE(PG8_SA(1, 0), a3, voffA);
            PG8_WAIT_V(8); PG8_WAIT_L(0); PG8_BAR; PG8_MMA(1, 0, At, B0); PG8_MMA(1, 1, At, B1); PG8_BAR; PG8_SCHED;
            } else {
            PG8_LDB(B0, 0, 0); PG8_SCHED; PG8_LDA(At, 0, 0); PG8_STAGE(PG8_SA(1, 1), a1 + hstepA, voffA);
            PG8_WAIT_L(8); PG8_BAR; PG8_WAIT_L(0); PG8_MMA(0, 0, At, B0); PG8_BAR; PG8_SCHED;
            PG8_LDB(B1, 0, 1); PG8_STAGE(PG8_SB(0, 0), b2, voffB);
            PG8_BAR; PG8_WAIT_L(0); PG8_MMA(0, 1, At, B1); PG8_BAR;
            PG8_LDA(At, 0, 1); PG8_STAGE(PG8_SA(0, 0), a2, voffA);
            PG8_BAR; PG8_WAIT_L(0); PG8_MMA(1, 0, At, B0); PG8_BAR; PG8_SCHED;
            PG8_STAGE(PG8_SB(0, 1), b2 + hstepB, voffB);
            PG8_WAIT_V(6); PG8_BAR; PG8_MMA(1, 1, At, B1); PG8_BAR;
            PG8_LDB(B0, 1, 0); PG8_SCHED; PG8_LDA(At, 1, 0); PG8_STAGE(PG8_SA(0, 1), a2 + hstepA, voffA);
            PG8_WAIT_L(8); PG8_BAR; PG8_WAIT_L(0); PG8_MMA(0, 0, At, B0); PG8_BAR; PG8_SCHED;
            PG8_LDB(B1, 1, 1); PG8_STAGE(PG8_SB(1, 0), b3, voffB);
            PG8_BAR; PG8_WAIT_L(0); PG8_MMA(0, 1, At, B1); PG8_BAR;
            PG8_LDA(At, 1, 1); PG8_STAGE(PG8_SA(1, 0), a3, voffA);
            PG8_BAR; PG8_WAIT_L(0); PG8_MMA(1, 0, At, B0); PG8_BAR; PG8_SCHED;
            PG8_STAGE(PG8_SB(1, 1), b3 + hstepB, voffB);
            PG8_WAIT_V(6); PG8_BAR; PG8_MMA(1, 1, At, B1); PG8_BAR;
            }
        }
        if constexpr (ALIGN_EPI) { if (wr == 0) PG8_BAR; }
        E(acc, cur, wr, wc, fr, fq, rsv); S.done(cur);
        if (has_next) PG8_RS(nxt);
        if (!has_next) break;
#pragma unroll
        for (int a = 0; a < 2; ++a)
#pragma unroll
            for (int b = 0; b < 2; ++b)
#pragma unroll
                for (int m = 0; m < 4; ++m)
#pragma unroll
                    for (int n = 0; n < 2; ++n) acc[a][b][m][n] = (f32x4){0.f, 0.f, 0.f, 0.f};
        cur = nxt; cA = nA; cB = nB; ++ui;
        if constexpr (ALIGN_EPI) { if (wr == 1) PG8_BAR; }
    }
    PG8_WAIT_V(0);
    if constexpr (!ALIGN_EPI) { if (wr == 0) PG8_BAR; }
    PG8_BAR;
#undef PG8_SA
#undef PG8_SB
#undef PG8_STAGE
#undef PG8_LDA
#undef PG8_LDB
#undef PG8_MMA
#undef PG8_WAIT_V
#undef PG8_WAIT_L
#undef PG8_BAR
#undef PG8_SCHED
#undef PG8_UA
#undef PG8_UB
#undef PG8_RS
}

__device__ __forceinline__ float row_scale(const float* ssq, int row) { const f32x4 a = *(const f32x4*)(ssq + (size_t)row * 8), b = *(const f32x4*)(ssq + (size_t)row * 8 + 4);
    return __builtin_amdgcn_rsqf((((a[0] + a[1]) + (a[2] + a[3])) + ((b[0] + b[1]) + (b[2] + b[3]))) * (1.0f / 2048.0f) + 1e-6f); }
__device__ __forceinline__ void unpack8(u32x4 w, f32x4& a, f32x4& b) { a[0] = __uint_as_float(w.x << 16); a[1] = __uint_as_float(w.x & 0xffff0000u); a[2] = __uint_as_float(w.y << 16); a[3] = __uint_as_float(w.y & 0xffff0000u);
    b[0] = __uint_as_float(w.z << 16); b[1] = __uint_as_float(w.z & 0xffff0000u); b[2] = __uint_as_float(w.w << 16); b[3] = __uint_as_float(w.w & 0xffff0000u); }
__device__ __forceinline__ u32x4 pack8(f32x4 a, f32x4 b) { u32x4 w; w.x = cvt_pk_bf16(a[0], a[1]); w.y = cvt_pk_bf16(a[2], a[3]); w.z = cvt_pk_bf16(b[0], b[1]); w.w = cvt_pk_bf16(b[2], b[3]); return w; }

struct EpiResid {
    static constexpr bool PERM = true, NEEDS_RS = false;
    float* X; bf16_t* XB; float* ssq; const float* cs; PG8_LAS float* red;
    __device__ __forceinline__ void operator()(const f32x4 (&acc)[2][2][4][2], const Unit& u, int wr, int wc, int fr, int fq, const float (&rsv)[2][4]) const {
        const int row0 = u.pm * BM + wr * 64 + fr, col0 = u.pn * BM + wc * 32 + 8 * fq;
        f32x4 cv[2][2];
#pragma unroll
        for (int bj = 0; bj < 2; ++bj)
#pragma unroll
            for (int n = 0; n < 2; ++n) cv[bj][n] = cs ? *(const f32x4*)(cs + col0 + bj * HALF + 4 * n) : (f32x4){1.f, 1.f, 1.f, 1.f};
#pragma unroll
        for (int ai = 0; ai < 2; ++ai)
#pragma unroll
            for (int m = 0; m < 4; ++m) { const int row = row0 + ai * HALF + m * 16; float ss = 0.f;
#pragma unroll
                for (int bj = 0; bj < 2; ++bj) { bf16_t* xp = XB + (size_t)row * D + col0 + bj * HALF;
                    f32x4 a, b; unpack8(*(const u32x4*)xp, a, b);
                    a += acc[ai][bj][m][0] * cv[bj][0]; b += acc[ai][bj][m][1] * cv[bj][1];
                    const u32x4 w = pack8(a, b); *(u32x4*)xp = w; unpack8(w, a, b);
                    ss += (a[0] * a[0] + a[1] * a[1]) + (a[2] * a[2] + a[3] * a[3]) + (b[0] * b[0] + b[1] * b[1]) + (b[2] * b[2] + b[3] * b[3]); }
                ss += __shfl_xor(ss, 16); ss += __shfl_xor(ss, 32);
                if (fq == 0) red[(ai * HALF + wr * 64 + m * 16 + fr) * 4 + wc] = ss;
                asm volatile("" ::: "memory"); }
        asm volatile("s_waitcnt lgkmcnt(0)" ::: "memory"); __builtin_amdgcn_s_barrier(); asm volatile("" ::: "memory");
        const int t = wc * 64 + fq * 16 + fr;
        if (wr == 0) { const f32x4 v = *(const PG8_LAS f32x4*)(red + t * 4); ssq[(size_t)(u.pm * BM + t) * 8 + u.pn] = (v[0] + v[1]) + (v[2] + v[3]); }
    }
};
struct EpiFfn1 {
    static constexpr bool PERM = true, NEEDS_RS = true;
    bf16_t* H; const float* ssq;
    __device__ __forceinline__ void operator()(const f32x4 (&acc)[2][2][4][2], const Unit& u, int wr, int wc, int fr, int fq, const float (&rsv)[2][4]) const {
        const int row0 = u.pm * BM + wr * 64 + fr, col0 = u.pn * HALF + wc * 32 + 8 * fq;
#pragma unroll
        for (int ai = 0; ai < 2; ++ai)
#pragma unroll
            for (int m = 0; m < 4; ++m) { const int row = row0 + ai * HALF + m * 16; const float rs = rsv[ai][m];
                float g[8], sg[8]; f32x4 o[2];
#pragma unroll
                for (int j = 0; j < 8; ++j) g[j] = acc[ai][0][m][j >> 2][j & 3] * rs;
                sigmoid8(g, sg);
#pragma unroll
                for (int j = 0; j < 8; ++j) o[j >> 2][j & 3] = (g[j] * sg[j]) * (acc[ai][1][m][j >> 2][j & 3] * rs);
                *(u32x4*)(H + (size_t)row * FF + col0) = pack8(o[0], o[1]); }
    }
};
struct EpiHgrn {
    static constexpr bool PERM = true, NEEDS_RS = true;
    bf16_t* Q; float* LOGF; bf16_t* V; bf16_t* GS; const float* ssq; const float* lb;
    __device__ __forceinline__ void operator()(const f32x4 (&acc)[2][2][4][2], const Unit& u, int wr, int wc, int fr, int fq, const float (&rsv)[2][4]) const {
        const int seg = u.pn >> 3, row0 = u.pm * BM + wr * 64 + fr, col0 = (u.pn & 7) * BM + wc * 32 + 8 * fq;
        f32x4 lbv[2][2];
        if (seg == 1) {
#pragma unroll
            for (int bj = 0; bj < 2; ++bj)
#pragma unroll
                for (int n = 0; n < 2; ++n) lbv[bj][n] = *(const f32x4*)(lb + col0 + bj * HALF + 4 * n);
        }
#pragma unroll
        for (int ai = 0; ai < 2; ++ai)
#pragma unroll
            for (int m = 0; m < 4; ++m) { const int row = row0 + ai * HALF + m * 16; const float rs = rsv[ai][m];
#pragma unroll
                for (int bj = 0; bj < 2; ++bj) { f32x4 a = acc[ai][bj][m][0] * rs, b = acc[ai][bj][m][1] * rs; const size_t off = (size_t)row * D + col0 + bj * HALF;
                    if (seg == 1) { float z[8], sg[8];
#pragma unroll
                        for (int j = 0; j < 4; ++j) { z[j] = a[j]; z[4 + j] = b[j]; }
                        sigmoid8(z, sg);
#pragma unroll
                        for (int j = 0; j < 8; ++j) { const float l = lbv[bj][j >> 2][j & 3]; z[j] = fmaxf(l + (1.f - l) * sg[j], 1e-6f); }
#pragma unroll
                        for (int j = 0; j < 8; ++j) z[j] = __builtin_amdgcn_logf(z[j]);
#pragma unroll
                        for (int j = 0; j < 4; ++j) { a[j] = z[j]; b[j] = z[4 + j]; }
                        u32x4 lw_; lw_.x = pk_f16(a[0], a[1]); lw_.y = pk_f16(a[2], a[3]); lw_.z = pk_f16(b[0], b[1]); lw_.w = pk_f16(b[2], b[3]);
                        *(u32x4*)((unsigned short*)LOGF + off) = lw_;
                    } else {
                        if (seg == 3) { float z[8], sg[8];
#pragma unroll
                            for (int j = 0; j < 4; ++j) { z[j] = a[j]; z[4 + j] = b[j]; }
                            sigmoid8(z, sg);
#pragma unroll
                            for (int j = 0; j < 4; ++j) { a[j] = z[j] * sg[j]; b[j] = z[4 + j] * sg[4 + j]; } }
                        bf16_t* dst = (bf16_t*)((char*)Q + (size_t)(seg ? seg + 1 : 0) * (65 * MiB));
                        *(u32x4*)(dst + off) = pack8(a, b); } } }
    }
};
struct EpiQkv {
    static constexpr bool PERM = true, NEEDS_RS = true;
    bf16_t* Q; bf16_t* Kb; bf16_t* Vb; float* out; const float* ssq;
    __device__ __forceinline__ void operator()(const f32x4 (&acc)[2][2][4][2], const Unit& u, int wr, int wc, int fr, int fq, const float (&rsv)[2][4]) const {
        const int seg = u.pn >> 3, row0 = u.pm * BM + wr * 64 + fr, col0 = (u.pn & 7) * BM + wc * 32 + 8 * fq;
        bf16_t* dst = (bf16_t*)((char*)Q + (size_t)(seg + (seg >> 1)) * (65 * MiB));
        const bool smp = u.pm >= 64; const int frow0 = smp ? row0 - MP : row0;
        float* fo = out + (smp ? OFF_K_S : OFF_K_P) + (size_t)(seg ? seg - 1 : 0) * (smp ? (OFF_V_S - OFF_K_S) : (OFF_V_P - OFF_K_P));
#pragma unroll
        for (int ai = 0; ai < 2; ++ai)
#pragma unroll
            for (int m = 0; m < 4; ++m) { const int row = row0 + ai * HALF + m * 16; const float rs = rsv[ai][m];
#pragma unroll
                for (int bj = 0; bj < 2; ++bj) { const f32x4 a = acc[ai][bj][m][0] * rs, b = acc[ai][bj][m][1] * rs; const size_t off = (size_t)row * D + col0 + bj * HALF;
                    *(u32x4*)(dst + off) = pack8(a, b);
                    if (seg) { float* p = fo + (size_t)(frow0 + ai * HALF + m * 16) * D + col0 + bj * HALF; *(f32x4*)p = a; *(f32x4*)(p + 4) = b; } } }
    }
};
}

namespace sk {
__device__ __forceinline__ int crow(int r, int hi) { return (r & 3) + 8 * (r >> 2) + 4 * hi; }
__device__ __forceinline__ float row_scale_s(const float* ssqS, int row) { float t = 0.f;
#pragma unroll
    for (int i = 0; i < 16; ++i) { const f32x4 a = *(const f32x4*)(ssqS + (size_t)row * 64 + 4 * i); t += (a[0] + a[1]) + (a[2] + a[3]); }
    return __builtin_amdgcn_rsqf(t * (1.0f / 2048.0f) + 1e-6f); }
template <class Epi, int NC>
__device__ __forceinline__ void skinny_phase(const bf16* __restrict__ A, int lda, int a_goff, const bf16* __restrict__ Bt, int ldb, int K, int ncg, int vcu, int G, const Epi& E, LAS float* rs_tab, LAS unsigned char* lds) {
    const int tid = opaque_tid(), w = __builtin_amdgcn_readfirstlane(tid >> 6), lane = tid & 63, r32 = lane & 31, hi = lane >> 5, rblk = w & 1, kq = w >> 1;
    if (Epi::NEEDS_RS) { if (tid < 256) rs_tab[tid] = row_scale_s(E.ssqS, tid); }
    asm volatile("s_waitcnt lgkmcnt(0)" ::: "memory"); __builtin_amdgcn_s_barrier(); asm volatile("" ::: "memory");
    constexpr int BUF = 32768 + NC * 16384, NW2 = 2 * NC;
    const int srow = tid >> 5, sslot = tid & 31, nsc = K / 256;
    const int st0 = srow * 512 + ((sslot ^ (srow & 15)) << 4);
    const int rrow = 32 * rblk + r32;
    const int NU = 4 * (ncg / NC);
    bf16x8 ra[3][4], rw[3][NW2];
    const bf16* pa = A; const bf16* pw[NW2];
#pragma unroll
    for (int i = 0; i < NW2; ++i) pw[i] = Bt;
#define SK_PTRS(u_) do { const int cg_ = ((u_) >> 2) * NC, rb_ = (u_) & 3; \
        pa = A + (size_t)(64 * rb_ + srow) * lda + (size_t)(cg_ >> 4) * a_goff + sslot * 8; \
        _Pragma("unroll") for (int i = 0; i < NW2; ++i) pw[i] = Bt + (size_t)E.wrow(cg_ + (i >> 1), srow + 16 * (i & 1)) * ldb + sslot * 8; \
        asm volatile("" : "+v"(pa)); \
        _Pragma("unroll") for (int i = 0; i < NW2; ++i) asm volatile("" : "+v"(pw[i])); } while (0)
#define SK_LOAD(s_, c) do { _Pragma("unroll") for (int i = 0; i < 4; ++i) ra[s_][i] = *(const bf16x8*)(pa + (size_t)(16 * i) * lda + (c) * 256); \
        _Pragma("unroll") for (int i = 0; i < NW2; ++i) rw[s_][i] = *(const bf16x8*)(pw[i] + (c) * 256); } while (0)
#define SK_LOAD3() do { SK_LOAD(0, 0); if (1 < nsc) SK_LOAD(1, 1); if (2 < nsc) SK_LOAD(2, 2); } while (0)
#define SK_WRITE(s_, b) do { LAS unsigned char* bb = lds + (b) * BUF; _Pragma("unroll") for (int i = 0; i < 4; ++i) *(LAS bf16x8*)(bb + st0 + i * 8192) = ra[s_][i]; \
        _Pragma("unroll") for (int i = 0; i < NW2; ++i) *(LAS bf16x8*)(bb + 32768 + st0 + i * 8192) = rw[s_][i]; } while (0)
#define SK_STEP(j) do { const int c = c3 + (j); if (c < nsc) { \
            if (c + 1 < nsc) SK_WRITE(((j) + 1) % 3, (c + 1) & 1); \
            if (c + 3 < nsc) SK_LOAD((j), c + 3); \
            const LAS unsigned char* bb = lds + (c & 1) * BUF; \
            _Pragma("unroll") for (int i = 0; i < 4; ++i) { const int sl = 8 * kq + 2 * i + hi; \
                const bf16x8 af = *(const LAS bf16x8*)(bb + rrow * 512 + ((sl ^ (rrow & 15)) << 4)); \
                _Pragma("unroll") for (int g = 0; g < NC; ++g) { const bf16x8 wf = *(const LAS bf16x8*)(bb + 32768 + (32 * g + r32) * 512 + ((sl ^ (r32 & 15)) << 4)); \
                    acc[g] = __builtin_amdgcn_mfma_f32_32x32x16_bf16(wf, af, acc[g], 0, 0, 0); } } \
            asm volatile("s_waitcnt lgkmcnt(0)" ::: "memory"); __builtin_amdgcn_s_barrier(); asm volatile("" ::: "memory"); } } while (0)
    int u = vcu;
    if (u < NU) { SK_PTRS(u); SK_LOAD3(); }
#pragma unroll 1
    while (u < NU) {
        const int cg = (u >> 2) * NC, rb = u & 3;
        f32x16 acc[NC] = {};
        SK_WRITE(0, 0);
        asm volatile("s_waitcnt lgkmcnt(0)" ::: "memory"); __builtin_amdgcn_s_barrier(); asm volatile("" ::: "memory");
#pragma unroll 1
        for (int c3 = 0; c3 < nsc; c3 += 3) { SK_STEP(0); SK_STEP(1); SK_STEP(2); }
        const int un = u + G;
        if (un < NU) { SK_PTRS(un); SK_LOAD3(); }
        LAS float* pb = (LAS float*)lds + (w * NC) * 1024 + lane;
        asm volatile("" : "+v"(pb));
#pragma unroll
        for (int g = 0; g < NC; ++g)
#pragma unroll
            for (int r = 0; r < 16; ++r) pb[(g * 16 + r) * 64] = acc[g][r];
        asm volatile("s_waitcnt lgkmcnt(0)" ::: "memory"); __builtin_amdgcn_s_barrier(); asm volatile("" ::: "memory");
        if (kq == 0) {
            const int row = 64 * rb + rrow; const float rs = Epi::NEEDS_RS ? rs_tab[row] : 1.f;
#pragma unroll
            for (int g = 0; g < NC; ++g) {
#pragma unroll
                for (int r = 0; r < 16; ++r) { const int o_ = (g * 16 + r) * 64; acc[g][r] = ((pb[o_] + pb[o_ + 2 * NC * 1024]) + pb[o_ + 4 * NC * 1024]) + pb[o_ + 6 * NC * 1024]; }
                E(acc[g], cg + g, row, hi, rs); }
        }
        asm volatile("s_waitcnt lgkmcnt(0)" ::: "memory"); __builtin_amdgcn_s_barrier(); asm volatile("" ::: "memory");
        u = un;
    }
#undef SK_PTRS
#undef SK_LOAD
#undef SK_LOAD3
#undef SK_WRITE
#undef SK_STEP
}
__device__ __forceinline__ u32x2 pack4(float a, float b, float c, float d) { u32x2 w; w.x = cvt_pk_bf16(a, b); w.y = cvt_pk_bf16(c, d); return w; }
struct SkResid {
    static constexpr bool NEEDS_RS = false;
    float* X; bf16* XB; float* ssqS; const float* cs;
    __device__ __forceinline__ int wrow(int u, int m) const { return 32 * u + m; }
    __device__ __forceinline__ void operator()(const f32x16& acc, int u, int row, int hi, float) const {
        float ss = 0.f;
#pragma unroll
        for (int q = 0; q < 4; ++q) { const int c = 32 * u + 8 * q + 4 * hi; bf16* xp = XB + (size_t)(MP + row) * D + c;
            const u32x2 w0 = *(const u32x2*)xp; f32x4 xv = {__uint_as_float(w0.x << 16), __uint_as_float(w0.x & 0xffff0000u), __uint_as_float(w0.y << 16), __uint_as_float(w0.y & 0xffff0000u)};
            f32x4 av = {acc[4 * q], acc[4 * q + 1], acc[4 * q + 2], acc[4 * q + 3]};
            if (cs) av *= *(const f32x4*)(cs + c);
            xv += av; const u32x2 w1 = pack4(xv[0], xv[1], xv[2], xv[3]); *(u32x2*)xp = w1;
            xv = (f32x4){__uint_as_float(w1.x << 16), __uint_as_float(w1.x & 0xffff0000u), __uint_as_float(w1.y << 16), __uint_as_float(w1.y & 0xffff0000u)};
            ss += (xv[0] * xv[0] + xv[1] * xv[1]) + (xv[2] * xv[2] + xv[3] * xv[3]); }
        ss += __shfl_xor(ss, 32);
        if (hi == 0) ssqS[(size_t)row * 64 + u] = ss;
    }
};
struct SkFfn1 {
    static constexpr bool NEEDS_RS = true;
    bf16* H; const float* ssqS;
    __device__ __forceinline__ int wrow(int u, int m) const { const int j = 16 * u + (m & 15); return (j >> 7) * 256 + (j & 127) + (m >> 4) * 128; }
    __device__ __forceinline__ void operator()(const f32x16& acc, int u, int row, int hi, float rs) const {
#pragma unroll
        for (int q = 0; q < 2; ++q) { float o[4];
#pragma unroll
            for (int i = 0; i < 4; ++i) { const float gt = acc[4 * q + i] * rs, up = acc[4 * q + i + 8] * rs; o[i] = gt * sigmoidf_(gt) * up; }
            *(u32x2*)(H + (size_t)(MP + row) * FF + 16 * u + 8 * q + 4 * hi) = pack4(o[0], o[1], o[2], o[3]); }
    }
};
struct SkHgrn {
    static constexpr bool NEEDS_RS = true;
    bf16* Q; float* LOGF; const float* ssqS; const float* lb;
    __device__ __forceinline__ int wrow(int u, int m) const { return 32 * u + m; }
    __device__ __forceinline__ void operator()(const f32x16& acc, int u, int row, int hi, float rs) const {
        const int seg = u >> 6;
#pragma unroll
        for (int q = 0; q < 4; ++q) { const int c = 32 * (u & 63) + 8 * q + 4 * hi; const size_t off = (size_t)(MP + row) * D + c;
            f32x4 a = {acc[4 * q] * rs, acc[4 * q + 1] * rs, acc[4 * q + 2] * rs, acc[4 * q + 3] * rs};
            if (seg == 1) { const f32x4 l = *(const f32x4*)(lb + c);
#pragma unroll
                for (int j = 0; j < 4; ++j) a[j] = __builtin_amdgcn_logf(fmaxf(l[j] + (1.f - l[j]) * sigmoidf_(a[j]), 1e-6f));
                u32x2 lw_; lw_.x = pk_f16(a[0], a[1]); lw_.y = pk_f16(a[2], a[3]); *(u32x2*)((unsigned short*)LOGF + off) = lw_;
            } else {
                if (seg == 3) {
#pragma unroll
                    for (int j = 0; j < 4; ++j) a[j] = a[j] * sigmoidf_(a[j]); }
                bf16* dst = (bf16*)((char*)Q + (size_t)(seg ? seg + 1 : 0) * (65 * MiB));
                *(u32x2*)(dst + off) = pack4(a[0], a[1], a[2], a[3]); } }
    }
};
struct SkQkv {
    static constexpr bool NEEDS_RS = true;
    bf16* Q; float* out; const float* ssqS;
    __device__ __forceinline__ int wrow(int u, int m) const { return 32 * u + m; }
    __device__ __forceinline__ void operator()(const f32x16& acc, int u, int row, int hi, float rs) const {
        const int seg = u >> 6;
        bf16* dst = (bf16*)((char*)Q + (size_t)(seg + (seg >> 1)) * (65 * MiB));
        float* fo = out + OFF_K_S + (size_t)(seg ? seg - 1 : 0) * (OFF_V_S - OFF_K_S);
#pragma unroll
        for (int q = 0; q < 4; ++q) { const int c = 32 * (u & 63) + 8 * q + 4 * hi;
            const f32x4 a = {acc[4 * q] * rs, acc[4 * q + 1] * rs, acc[4 * q + 2] * rs, acc[4 * q + 3] * rs};
            *(u32x2*)(dst + (size_t)(MP + row) * D + c) = pack4(a[0], a[1], a[2], a[3]);
            if (seg) *(f32x4*)(fo + (size_t)row * D + c) = a; }
    }
};
}

namespace att {
constexpr int KVBLK = 64, QBLK = 32, NW = 8, LD = 2048;
constexpr float SCALE = ATT_SCALE, THR = 8.f;
constexpr int SHM_V = KVBLK * 128 * 2, SHM_K = KVBLK * 128 * 2;
#define KSWZ(row, colB) ((row) * 256 + ((colB) ^ (((row) & 7) << 4)))
#define SBAR() __builtin_amdgcn_sched_barrier(0)
__device__ __forceinline__ int crow(int r, int hi) { return (r & 3) + 8 * (r >> 2) + 4 * hi; }
__device__ __forceinline__ void partialSM(f32x16& p0, f32x16& p1, float& m_reg, float& mn, float& alpha) {
  constexpr float C = SCALE * 1.4426950408889634f;
  float pmax = fmaxf(p0[0], p1[0]);
#pragma unroll
  for (int r = 1; r < 16; ++r) pmax = __builtin_fmaxf(__builtin_fmaxf(pmax, p0[r]), p1[r]);
  { auto rr = __builtin_amdgcn_permlane32_swap(__float_as_uint(pmax), __float_as_uint(pmax), false, false);
    pmax = fmaxf(__uint_as_float(rr[0]), __uint_as_float(rr[1])); }
  if (__builtin_expect(__all(pmax - m_reg <= THR / SCALE), 1)) { mn = m_reg; alpha = 1.f; }
  else { mn = fmaxf(m_reg, pmax); alpha = __builtin_amdgcn_exp2f((m_reg - mn) * C); m_reg = mn; }
  float mnC = -mn * C;
#pragma unroll
  for (int r = 0; r < 16; ++r) p0[r] = fmaf(p0[r], C, mnC);
#pragma unroll
  for (int r = 0; r < 16; ++r) p1[r] = fmaf(p1[r], C, mnC);
#pragma unroll
  for (int r = 0; r < 16; ++r) p0[r] = __builtin_amdgcn_exp2f(p0[r]);
}
__device__ __forceinline__ void finishSM(f32x16& p0, f32x16& p1, float alpha, float& l_reg, bf16x8& pa0, bf16x8& pa1, bf16x8& pa2, bf16x8& pa3) {
#pragma unroll
  for (int r = 0; r < 16; ++r) p1[r] = __builtin_amdgcn_exp2f(p1[r]);
  float ps = 0;
#pragma unroll
  for (int r = 0; r < 16; ++r) ps += p0[r];
#pragma unroll
  for (int r = 0; r < 16; ++r) ps += p1[r];
  { auto rr = __builtin_amdgcn_permlane32_swap(__float_as_uint(ps), __float_as_uint(ps), false, false);
    ps = __uint_as_float(rr[0]) + __uint_as_float(rr[1]); }
  l_reg = l_reg * alpha + ps;
#define PK4(P, BASE, OUT) do { unsigned a0 = cvt_pk_bf16(P[BASE + 0], P[BASE + 1]), a1 = cvt_pk_bf16(P[BASE + 2], P[BASE + 3]);   \
    unsigned b0 = cvt_pk_bf16(P[BASE + 4], P[BASE + 5]), b1 = cvt_pk_bf16(P[BASE + 6], P[BASE + 7]);                              \
    auto r0 = __builtin_amdgcn_permlane32_swap(a0, b0, false, false); auto r1 = __builtin_amdgcn_permlane32_swap(a1, b1, false, false); \
    u32x4 w = {r0[0], r1[0], r0[1], r1[1]}; OUT = *reinterpret_cast<bf16x8*>(&w); } while (0)
  PK4(p0, 0, pa0); PK4(p0, 8, pa1); PK4(p1, 0, pa2); PK4(p1, 8, pa3);
#undef PK4
}
__device__ __forceinline__ void qkt(f32x16& p0, f32x16& p1, const char* Ks, const bf16x8* qr, int r32, int hi) {
  p0 = f32x16{}; p1 = f32x16{};
#pragma unroll
  for (int d0 = 0; d0 < 8; ++d0) { int cb = (d0 * 16 + hi * 8) * 2;
    bf16x8 b0 = *reinterpret_cast<const bf16x8*>(Ks + KSWZ(r32, cb));
    bf16x8 b1 = *reinterpret_cast<const bf16x8*>(Ks + KSWZ(32 + r32, cb));
    p0 = __builtin_amdgcn_mfma_f32_32x32x16_bf16(b0, qr[d0], p0, 0, 0, 0);
    p1 = __builtin_amdgcn_mfma_f32_32x32x16_bf16(b1, qr[d0], p1, 0, 0, 0); }
}
__device__ __forceinline__ int v_st(int k, int c) { const int kk = (k & ~0xC) | ((k & 4) << 1) | ((k & 8) >> 1); return ((kk >> 3) * 4 + (c >> 5)) * 512 + ((kk & 7) * 32 + (c & 31)) * 2; }
__device__ __forceinline__ int v_rd_base(int lane) { return ((lane & 3) << 3) | (((lane >> 2) & 3) << 6) | (((lane >> 4) & 1) << 5) | (((lane >> 5) & 1) << 8); }
constexpr int v_rd_off(int d0, int ks, int half) { return d0 * 512 + ks * 4096 + half * 2048; }
template <int OFF> __device__ __forceinline__ s16x4 tr_read(int vb) {
  s16x4 r; asm volatile("ds_read_b64_tr_b16 %0, %1 offset:%2" : "=&v"(r) : "v"(vb), "i"(OFF) : "memory"); return r;
}
template <int D0> __device__ __forceinline__ void pv_one(f32x16& od, int vb, bf16x8 pa0, bf16x8 pa1, bf16x8 pa2, bf16x8 pa3) {
  const s16x4 l0 = tr_read<v_rd_off(D0, 0, 0)>(vb), h0 = tr_read<v_rd_off(D0, 0, 1)>(vb), l1 = tr_read<v_rd_off(D0, 1, 0)>(vb), h1 = tr_read<v_rd_off(D0, 1, 1)>(vb);
  const s16x4 l2 = tr_read<v_rd_off(D0, 2, 0)>(vb), h2 = tr_read<v_rd_off(D0, 2, 1)>(vb), l3 = tr_read<v_rd_off(D0, 3, 0)>(vb), h3 = tr_read<v_rd_off(D0, 3, 1)>(vb);
  asm volatile("s_waitcnt lgkmcnt(0)" ::: "memory"); SBAR();
#define PK(L, H) (bf16x8){L[0], L[1], L[2], L[3], H[0], H[1], H[2], H[3]}
  od = __builtin_amdgcn_mfma_f32_32x32x16_bf16(pa0, PK(l0, h0), od, 0, 0, 0);
  od = __builtin_amdgcn_mfma_f32_32x32x16_bf16(pa1, PK(l1, h1), od, 0, 0, 0);
  od = __builtin_amdgcn_mfma_f32_32x32x16_bf16(pa2, PK(l2, h2), od, 0, 0, 0);
  od = __builtin_amdgcn_mfma_f32_32x32x16_bf16(pa3, PK(l3, h3), od, 0, 0, 0);
#undef PK
}
template <int D0> __device__ __forceinline__ void pv_two(f32x16& oa, f32x16& ob, int vb, bf16x8 pa0, bf16x8 pa1, bf16x8 pa2, bf16x8 pa3, bf16x8 pb0, bf16x8 pb1, bf16x8 pb2, bf16x8 pb3) {
  const s16x4 l0 = tr_read<v_rd_off(D0, 0, 0)>(vb), h0 = tr_read<v_rd_off(D0, 0, 1)>(vb), l1 = tr_read<v_rd_off(D0, 1, 0)>(vb), h1 = tr_read<v_rd_off(D0, 1, 1)>(vb);
  const s16x4 l2 = tr_read<v_rd_off(D0, 2, 0)>(vb), h2 = tr_read<v_rd_off(D0, 2, 1)>(vb), l3 = tr_read<v_rd_off(D0, 3, 0)>(vb), h3 = tr_read<v_rd_off(D0, 3, 1)>(vb);
  asm volatile("s_waitcnt lgkmcnt(0)" ::: "memory"); SBAR();
#define PK2(L, H) (bf16x8){L[0], L[1], L[2], L[3], H[0], H[1], H[2], H[3]}
  oa = __builtin_amdgcn_mfma_f32_32x32x16_bf16(pa0, PK2(l0, h0), oa, 0, 0, 0); ob = __builtin_amdgcn_mfma_f32_32x32x16_bf16(pb0, PK2(l0, h0), ob, 0, 0, 0);
  oa = __builtin_amdgcn_mfma_f32_32x32x16_bf16(pa1, PK2(l1, h1), oa, 0, 0, 0); ob = __builtin_amdgcn_mfma_f32_32x32x16_bf16(pb1, PK2(l1, h1), ob, 0, 0, 0);
  oa = __builtin_amdgcn_mfma_f32_32x32x16_bf16(pa2, PK2(l2, h2), oa, 0, 0, 0); ob = __builtin_amdgcn_mfma_f32_32x32x16_bf16(pb2, PK2(l2, h2), ob, 0, 0, 0);
  oa = __builtin_amdgcn_mfma_f32_32x32x16_bf16(pa3, PK2(l3, h3), oa, 0, 0, 0); ob = __builtin_amdgcn_mfma_f32_32x32x16_bf16(pb3, PK2(l3, h3), ob, 0, 0, 0);
#undef PK2
}
__device__ __forceinline__ void pv_d0(f32x16* o, int vb, bf16x8 pa0, bf16x8 pa1, bf16x8 pa2, bf16x8 pa3) {
  pv_one<0>(o[0], vb, pa0, pa1, pa2, pa3); pv_one<1>(o[1], vb, pa0, pa1, pa2, pa3); pv_one<2>(o[2], vb, pa0, pa1, pa2, pa3); pv_one<3>(o[3], vb, pa0, pa1, pa2, pa3);
}
__device__ __forceinline__ void fix_prompt(f32x16& p0, f32x16& p1, int jt, int lim, int qrow0, int r32, int hi, const float* lut) {
  if (jt > lim) {
#pragma unroll
    for (int r = 0; r < 16; ++r) { p0[r] = -1e30f; p1[r] = -1e30f; }
  } else if (64 * jt >= qrow0 - 153) {
    const float* lp = lut + (64 * jt - (qrow0 + r32) + 192);
#pragma unroll
    for (int r = 0; r < 16; ++r) { p0[r] += lp[crow(r, hi)]; p1[r] += lp[32 + crow(r, hi)]; }
  }
}

#define RESC(a) do { if (__any((a) < 1.f)) { if (hi == 0) al_l[r32] = (a); asm volatile("s_waitcnt lgkmcnt(0)" ::: "memory"); \
    _Pragma("unroll") for (int d = 0; d < 4; ++d) _Pragma("unroll") for (int r = 0; r < 16; ++r) o[d][r] *= al_l[crow(r, hi)]; } } while (0)
__device__ __forceinline__ void attn_unit2(const bf16* __restrict__ Qb, const bf16* __restrict__ Kh, const bf16* __restrict__ Vh, bf16* __restrict__ Ob,
                                           int NT, int lim, int qrow0, const float* lut, char* lds, float* scr) {
  const int tid = opaque_tid(), wid = __builtin_amdgcn_readfirstlane(tid >> 6), lane = tid & 63, r32 = lane & 31, hi = lane >> 5, a = wid & 3;
  const bool isA = wid < 4;
  char* K_lds = lds; char* V_lds = lds + 32768; char* P_lds = lds + 98304 + a * 4096;
  float* alpha_l = scr + a * 32; float* l_l = scr + 256 + a * 32;
  unsigned kgo[2], vgo[2];
#pragma unroll
  for (int i = 0; i < 2; ++i) { const int pq = 2 * wid + i, g = 64 * pq + lane;
    { const int row = g >> 4, cc = (g & 15) ^ (row & 7); kgo[i] = (unsigned)(row * LD + cc * 8) * 2u; }
    { const int sub = g >> 5, kk = (sub >> 2) * 8 + ((g >> 2) & 7), k = (kk & ~0xC) | ((kk & 4) << 1) | ((kk & 8) >> 1), col = (sub & 3) * 32 + (g & 3) * 8; vgo[i] = (unsigned)(k * LD + col) * 2u; } }
  const int vrb = (int)(uintptr_t)V_lds + v_rd_base(lane);
  LAS char* K_las = (LAS char*)K_lds; LAS char* V_las = (LAS char*)V_lds;
#define DMA_K(j_, b_) do { const char* kb_ = (const char*)Kh + (size_t)(j_) * (64 * LD * 2); _Pragma("unroll") for (int i = 0; i < 2; ++i) \
    __builtin_amdgcn_global_load_lds((const unsigned*)(kb_ + kgo[i]), (LAS unsigned*)(K_las + (b_) * 16384 + (2 * wid + i) * 1024), 16, 0, 0); } while (0)
#define DMA_V(j_, b_) do { const char* vb_ = (const char*)Vh + (size_t)(j_) * (64 * LD * 2); _Pragma("unroll") for (int hf = 0; hf < 2; ++hf) _Pragma("unroll") for (int i = 0; i < 2; ++i) \
    __builtin_amdgcn_global_load_lds((const unsigned*)(vb_ + hf * 256 + vgo[i]), (LAS unsigned*)(V_las + (b_) * 32768 + hf * 16384 + (2 * wid + i) * 1024), 16, 0, 0); } while (0)
  DMA_K(0, 0);
  asm volatile("s_waitcnt vmcnt(0)" ::: "memory");
  __syncthreads();
  if (isA) {
    float m_reg = -1e30f, l_reg = 0; bf16x8 qr[8];
    const bf16* Qw = Qb + (long)(a * QBLK + r32) * LD + hi * 8;
#pragma unroll
    for (int d0 = 0; d0 < 8; ++d0) qr[d0] = *reinterpret_cast<const bf16x8*>(Qw + d0 * 16);
    for (int j = 0; j <= NT; ++j) {
      if (j + 1 < NT) DMA_K(j + 1, (j + 1) & 1);
      if (j < NT) DMA_V(j, j & 1);
      if (j < NT) {
        f32x16 p0, p1; float mn, al; bf16x8 pa0, pa1, pa2, pa3;
        __builtin_amdgcn_s_setprio(3);
        qkt(p0, p1, K_lds + (j & 1) * 16384, qr, r32, hi);
        fix_prompt(p0, p1, j, lim, qrow0, r32, hi, lut);
        partialSM(p0, p1, m_reg, mn, al);
        finishSM(p0, p1, al, l_reg, pa0, pa1, pa2, pa3);
        __builtin_amdgcn_s_setprio(0);
        char* ps = P_lds + (j & 1) * 16384 + lane * 16;
        *(bf16x8*)(ps) = pa0; *(bf16x8*)(ps + 1024) = pa1; *(bf16x8*)(ps + 2048) = pa2; *(bf16x8*)(ps + 3072) = pa3;
        if (hi == 0) alpha_l[(j & 1) * 128 + r32] = al;
      }
      asm volatile("s_waitcnt vmcnt(0)" ::: "memory");
      __syncthreads();
    }
    if (hi == 0) l_l[r32] = l_reg;
    __syncthreads();
  } else {
    const int rp = a >> 1, ch = a & 1;
    const char* P0 = lds + 98304 + (2 * rp) * 4096; const float* al0 = scr + (2 * rp) * 32; const float* ll0 = scr + 256 + (2 * rp) * 32;
    f32x16 o[2][4] = {};
    for (int j = 0; j <= NT; ++j) {
      if (j + 1 < NT) DMA_K(j + 1, (j + 1) & 1);
      if (j < NT) DMA_V(j, j & 1);
      if (j >= 1) {
        const char* ps = P0 + ((j - 1) & 1) * 16384 + lane * 16;
        const bf16x8 pa0 = *(const bf16x8*)(ps), pa1 = *(const bf16x8*)(ps + 1024), pa2 = *(const bf16x8*)(ps + 2048), pa3 = *(const bf16x8*)(ps + 3072);
        const bf16x8 pb0 = *(const bf16x8*)(ps + 4096), pb1 = *(const bf16x8*)(ps + 4096 + 1024), pb2 = *(const bf16x8*)(ps + 4096 + 2048), pb3 = *(const bf16x8*)(ps + 4096 + 3072);
        const float* al = al0 + ((j - 1) & 1) * 128;
        const float al_a = al[r32], al_b = al[32 + r32];
        __builtin_amdgcn_sched_barrier(0);
        if (__any(al_a < 1.f) || __any(al_b < 1.f)) {
#pragma unroll
          for (int rb = 0; rb < 2; ++rb)
#pragma unroll
            for (int d = 0; d < 4; ++d)
#pragma unroll
              for (int r = 0; r < 16; ++r) o[rb][d][r] *= al[rb * 32 + crow(r, hi)]; }
        const int vb = vrb + ((j - 1) & 1) * 32768 + ch * 16384;
        pv_two<0>(o[0][0], o[1][0], vb, pa0, pa1, pa2, pa3, pb0, pb1, pb2, pb3); pv_two<1>(o[0][1], o[1][1], vb, pa0, pa1, pa2, pa3, pb0, pb1, pb2, pb3);
        pv_two<2>(o[0][2], o[1][2], vb, pa0, pa1, pa2, pa3, pb0, pb1, pb2, pb3); pv_two<3>(o[0][3], o[1][3], vb, pa0, pa1, pa2, pa3, pb0, pb1, pb2, pb3);
      }
      asm volatile("s_waitcnt vmcnt(0)" ::: "memory");
      __syncthreads();
    }
    __syncthreads();
#pragma unroll
    for (int rb = 0; rb < 2; ++rb) {
      float rli[16];
#pragma unroll
      for (int r = 0; r < 16; ++r) rli[r] = __builtin_amdgcn_rcpf(ll0[rb * 32 + crow(r, hi)]);
      bf16* Ow = Ob + (long)(64 * rp + 32 * rb) * LD + ch * 128;
#pragma unroll
      for (int r = 0; r < 16; ++r) { const int orow = crow(r, hi);
#pragma unroll
        for (int d0 = 0; d0 < 4; ++d0) { const unsigned w_ = cvt_pk_bf16(o[rb][d0][r] * rli[r], 0.f); Ow[(long)orow * LD + d0 * 32 + r32] = (bf16)(w_ & 0xffffu); } } }
  }
#undef DMA_K
#undef DMA_V
}

__device__ __forceinline__ void attn_sample_unit(int b, int h, int split, const bf16* __restrict__ Q, const float* __restrict__ cache_k, const float* __restrict__ cache_v,
                                                 const float* __restrict__ newk, const float* __restrict__ newv, float* __restrict__ part, const float* lut, char* lds, float* scr) {
  const int tid = opaque_tid(), wid = __builtin_amdgcn_readfirstlane(tid >> 6), lane = tid & 63, r32 = lane & 31, hi = lane >> 5;
  const int nT = split ? 33 : 32;
  if (wid >= 4) {
    const int lw = wid - 4;
    f32x4 kreg[16], vreg[16];
#define SL_LOAD(j) do { const bool isnew = ((j) == 32); \
      const float* kp = isnew ? newk + ((size_t)b * 16 + lw) * 2048 + h * 256 + lane * 4 : cache_k + ((size_t)b * 4096 + (size_t)split * 2048 + (size_t)(j) * 64 + lw) * 2048 + h * 256 + lane * 4; \
      const float* vp = isnew ? newv + ((size_t)b * 16 + lw) * 2048 + h * 256 + lane * 4 : cache_v + ((size_t)b * 4096 + (size_t)split * 2048 + (size_t)(j) * 64 + lw) * 2048 + h * 256 + lane * 4; \
      _Pragma("unroll") for (int i = 0; i < 16; ++i) { \
        if (!isnew || i < 4) { kreg[i] = __builtin_nontemporal_load(reinterpret_cast<const f32x4*>(kp)); vreg[i] = __builtin_nontemporal_load(reinterpret_cast<const f32x4*>(vp)); } \
        else { kreg[i] = (f32x4){0.f, 0.f, 0.f, 0.f}; vreg[i] = (f32x4){0.f, 0.f, 0.f, 0.f}; } \
        kp += 4 * 2048; vp += 4 * 2048; asm volatile("" : "+v"(kp), "+v"(vp)); } } while (0)
#define SL_WRITE(bufi) do { char* bb = lds + (bufi) * 65536; _Pragma("unroll") for (int i = 0; i < 16; ++i) { const int key = i * 4 + lw; \
      const int c = lane >> 5, db = (lane & 31) * 8; \
      u32x2 kw; kw.x = cvt_pk_bf16(kreg[i][0], kreg[i][1]); kw.y = cvt_pk_bf16(kreg[i][2], kreg[i][3]); \
      *reinterpret_cast<u32x2*>(bb + c * 16384 + KSWZ(key, db & ~15) + (db & 15)) = kw; \
      const int e = lane * 4, vh = e >> 7, cc = e & 127; \
      u32x2 vw; vw.x = cvt_pk_bf16(vreg[i][0], vreg[i][1]); vw.y = cvt_pk_bf16(vreg[i][2], vreg[i][3]); \
      *reinterpret_cast<u32x2*>(bb + 32768 + vh * 16384 + v_st(key, cc & ~7) + (cc & 7) * 2) = vw; } } while (0)
    SL_LOAD(0); SL_WRITE(0); SL_LOAD(1);
    __syncthreads();
    for (int j = 0; j < nT; ++j) {
      if (j + 1 < nT) { SL_WRITE((j + 1) & 1); if (j + 2 < nT) SL_LOAD(j + 2); }
      __syncthreads();
    }
#undef SL_LOAD
#undef SL_WRITE
  } else {
    const int c = wid & 1, vh = wid >> 1;
    float* li_l = scr + wid * 64; float* al_l = li_l + 32;
    float m_reg = -1e30f, l_reg = 0; f32x16 o[4] = {};
    const bf16* Qw = Q + (size_t)(MP + b * 16 + (r32 & 15)) * LD + h * 256 + c * 128 + hi * 8;
    __syncthreads();
    for (int j = 0; j < nT; ++j) {
      char* bb = lds + (j & 1) * 65536;
      f32x16 p0, p1; float mn, al; bf16x8 pa0, pa1, pa2, pa3; bf16x8 qr[8];
      asm volatile("" : "+v"(Qw));
#pragma unroll
      for (int d0 = 0; d0 < 8; ++d0) { bf16x8 v = *reinterpret_cast<const bf16x8*>(Qw + d0 * 16); if (r32 >= 16) v = (bf16x8){0, 0, 0, 0, 0, 0, 0, 0}; qr[d0] = v; }
      qkt(p0, p1, bb + c * 16384, qr, r32, hi);
      const int kbase = (j == 32) ? 4096 : split * 2048 + j * 64;
      if (kbase >= 3904) {
        const float* lp = lut + (kbase - (4096 + r32) + 192);
#pragma unroll
        for (int r = 0; r < 16; ++r) { p0[r] += lp[crow(r, hi)]; p1[r] += lp[32 + crow(r, hi)]; }
      }
      if (j == 32) {
#pragma unroll
        for (int r = 0; r < 16; ++r) { if (crow(r, hi) >= 16) p0[r] = -1e30f; p1[r] = -1e30f; }
      }
      partialSM(p0, p1, m_reg, mn, al);
      RESC(al);
      finishSM(p0, p1, al, l_reg, pa0, pa1, pa2, pa3); SBAR();
      pv_d0(o, (int)(uintptr_t)(bb + 32768 + vh * 16384) + v_rd_base(lane), pa0, pa1, pa2, pa3);
      __syncthreads();
    }
    float* pp = part + (size_t)((((b * 8 + h) * 2 + split) * 4) + c * 2 + vh) * 2112;
    if (hi == 0 && r32 < 16) { pp[r32] = m_reg; pp[16 + r32] = l_reg; }
#pragma unroll
    for (int d0 = 0; d0 < 4; ++d0)
#pragma unroll
      for (int r = 0; r < 8; ++r) pp[64 + crow(r, hi) * 128 + d0 * 32 + r32] = o[d0][r];
  }
#undef RESC
}
}

namespace hg {
constexpr int QG_OFF = 0, KG_OFF = 8704, KDT_OFF = 17408, DL_OFF = 25600, SSQP_OFF = 26624, ROWB = 272, RAW_OFF = 28672, RAW_SLOT = 20480;
__device__ __forceinline__ void row_prefix4(float x, int tq, float& pre, float& tot) {
    const auto s16 = __builtin_amdgcn_permlane16_swap(__float_as_uint(x), __float_as_uint(x), false, false);
    const float ev = __uint_as_float(s16[0]), od = __uint_as_float(s16[1]), pr = ev + od;
    const auto s32 = __builtin_amdgcn_permlane32_swap(__float_as_uint(pr), __float_as_uint(pr), false, false);
    const float lo = __uint_as_float(s32[0]), hi = __uint_as_float(s32[1]);
    tot = lo + hi; pre = tq == 0 ? 0.f : tq == 1 ? ev : tq == 2 ? lo : lo + ev;
}
template <bool FULL>
__device__ __forceinline__ void hgrn_prep(char* lds, int s, int w, int kc, int tq, int kpos, float& gsum, s16x4& vfrag, u32x2& gvp) {
    const int buf = s & 1;
    char* QG = lds + QG_OFF + buf * 4352; char* KG = lds + KG_OFF + buf * 4352; char* KDT = lds + KDT_OFF + buf * 4096;
    float* DL = (float*)(lds + DL_OFF + buf * 512);
    const char* raw = lds + RAW_OFF + buf * RAW_SLOT;
    float lf[4]; unsigned short qv[4], vv[4], gv[4];
#pragma unroll
    for (int j = 0; j < 4; ++j) { const int e = (4 * tq + j) * 128 + 16 * w + kc; lf[j] = h2f(*(const unsigned short*)(raw + e * 2)); vv[j] = *(const unsigned short*)(raw + 12288 + e * 2);
        if (FULL) { qv[j] = *(const unsigned short*)(raw + 8192 + e * 2); gv[j] = *(const unsigned short*)(raw + 16384 + e * 2); } }
    float G[4], glast;
    { const float c0 = lf[0], c1 = c0 + lf[1], c2 = c1 + lf[2], c3 = c2 + lf[3];
      float pre; row_prefix4(c3, tq, pre, glast);
      G[0] = pre + c0; G[1] = pre + c1; G[2] = pre + c2; G[3] = pre + c3; }
    float kd[4];
#pragma unroll
    for (int j = 0; j < 4; ++j) { const float kk = 1.f - __builtin_amdgcn_exp2f(lf[j]);
        kd[j] = kk * __builtin_amdgcn_exp2f(glast - G[j]);
        if (FULL) { const float qg = bf2f(qv[j]) * __builtin_amdgcn_exp2f(G[j]), kg = kk * __builtin_amdgcn_exp2f(fminf(-G[j], 115.f));
            const unsigned qk = cvt_pk_bf16(qg, kg);
            *(bf16*)(QG + (4 * tq + j) * ROWB + kpos * 2) = (bf16)(qk & 0xffffu);
            *(bf16*)(KG + (4 * tq + j) * ROWB + kpos * 2) = (bf16)(qk >> 16); }
        vfrag[j] = (short)vv[j]; }
    { u32x2 kw; kw.x = cvt_pk_bf16(kd[0], kd[1]); kw.y = cvt_pk_bf16(kd[2], kd[3]); *(u32x2*)(KDT + ((16 * w + kc) * 16 + 4 * tq) * 2) = kw; }
    DL[16 * w + kc] = __builtin_amdgcn_exp2f(glast);
    gsum += glast;
    if (FULL) { gvp.x = (unsigned)gv[0] | ((unsigned)gv[1] << 16); gvp.y = (unsigned)gv[2] | ((unsigned)gv[3] << 16); }
}
template <bool FULL>
__device__ __forceinline__ void hgrn_mma(char* lds, int s, int w, int kc, int tq, const s16x4 vfrag, f32x4 (&S)[8], f32x4& o) {
    const int buf = s & 1;
    const char* QG = lds + QG_OFF + buf * 4352; const char* KG = lds + KG_OFF + buf * 4352; const char* KDT = lds + KDT_OFF + buf * 4096;
    const float* DL = (const float*)(lds + DL_OFF + buf * 512); float* SSQP = (float*)(lds + SSQP_OFF + buf * 512);
    o = (f32x4){0.f, 0.f, 0.f, 0.f};
    if (FULL) {
        f32x4 st = {0.f, 0.f, 0.f, 0.f};
#pragma unroll
        for (int ks = 0; ks < 4; ++ks) {
            const bf16x8 qa = *(const bf16x8*)(QG + kc * ROWB + (32 * ks + 8 * tq) * 2), ka = *(const bf16x8*)(KG + kc * ROWB + (32 * ks + 8 * tq) * 2);
            u32x4 sw; sw.x = cvt_pk_bf16(S[2 * ks][0], S[2 * ks][1]); sw.y = cvt_pk_bf16(S[2 * ks][2], S[2 * ks][3]);
            sw.z = cvt_pk_bf16(S[2 * ks + 1][0], S[2 * ks + 1][1]); sw.w = cvt_pk_bf16(S[2 * ks + 1][2], S[2 * ks + 1][3]);
            o = __builtin_amdgcn_mfma_f32_16x16x32_bf16(qa, *reinterpret_cast<bf16x8*>(&sw), o, 0, 0, 0);
            st = __builtin_amdgcn_mfma_f32_16x16x32_bf16(ka, qa, st, 0, 0, 0); }
#pragma unroll
        for (int i = 0; i < 4; ++i) st[i] = (4 * tq + i <= kc) ? st[i] : 0.f;
        u32x2 sp; sp.x = cvt_pk_bf16(st[0], st[1]); sp.y = cvt_pk_bf16(st[2], st[3]);
        o = __builtin_amdgcn_mfma_f32_16x16x16bf16_1k(*reinterpret_cast<s16x4*>(&sp), vfrag, o, 0, 0, 0);
    }
#pragma unroll
    for (int kb = 0; kb < 8; ++kb) { const f32x4 dlv = *(const f32x4*)(DL + 16 * kb + 4 * tq);
        const s16x4 ka = *(const s16x4*)(KDT + ((16 * kb + kc) * 16 + 4 * tq) * 2);
        S[kb] = __builtin_amdgcn_mfma_f32_16x16x16bf16_1k(ka, vfrag, S[kb] * dlv, 0, 0, 0); }
    if (FULL) {
        float ss[4];
#pragma unroll
        for (int i = 0; i < 4; ++i) ss[i] = row16_sum(o[i] * o[i]);
#pragma unroll
        for (int i = 0; i < 4; ++i) SSQP[(4 * tq + i) * 8 + w] = ss[i];
    }
}
__device__ __forceinline__ void hgrn_fin(char* lds, int s, int w, int kc, int tq, int ch, int row0, float gn, const f32x4 o, const u32x2 gvp, bf16* __restrict__ O) {
    const float* SSQP = (const float*)(lds + SSQP_OFF + (s & 1) * 512);
#pragma unroll
    for (int i = 0; i < 4; ++i) { const float part = SSQP[(4 * tq + i) * 8 + (kc & 7)];
        const float tot = row16_sum(kc < 8 ? part : 0.f);
        const float rs = __builtin_amdgcn_rsqf(tot * (1.f / 128.f) + EPS);
        const unsigned gw_ = i < 2 ? gvp.x : gvp.y; const float gate = __uint_as_float((i & 1) ? (gw_ & 0xffff0000u) : (gw_ << 16));
        const float ov = o[i] * rs * gn * gate;
        O[(size_t)(row0 + 16 * s + 4 * tq + i) * D + ch] = (bf16)(cvt_pk_bf16(ov, 0.f) & 0xffffu); }
}
template <bool FULL, bool SBF>
__device__ __forceinline__ void hgrn_item(const bf16* __restrict__ Q, const float* __restrict__ LOGF, const bf16* __restrict__ V, const bf16* __restrict__ GS, bf16* __restrict__ O,
                                          int row0, int nsteps, int h, const void* __restrict__ Sin, void* __restrict__ Sout, float* __restrict__ Dout, const float* __restrict__ gain, char* lds) {
    const int tid = opaque_tid(), w = __builtin_amdgcn_readfirstlane(tid >> 6), lane = tid & 63, kc = lane & 15, tq = lane >> 4;
    const int ch = h * 128 + 16 * w + kc;
    const int kpos = 32 * (w >> 1) + 8 * (kc >> 2) + 4 * (w & 1) + (kc & 3);
    f32x4 S[8];
#pragma unroll
    for (int kb = 0; kb < 8; ++kb)
#pragma unroll
        for (int i = 0; i < 4; ++i) { const size_t so = (size_t)(16 * kb + 4 * tq + i) * 128 + 16 * w + kc; S[kb][i] = Sin ? (SBF ? bf2f(((const bf16*)Sin)[so]) : ((const float*)Sin)[so]) : 0.f; }
    float gsum = 0.f;
    const int t2 = tid & 255; const bool lo4 = tid < 256;
    const unsigned short* plf = (const unsigned short*)LOGF + (size_t)(row0 + (tid >> 5)) * D + h * 128 + 4 * (tid & 31);
    const size_t boff = (size_t)(row0 + (t2 >> 4)) * D + h * 128 + 8 * (t2 & 15);
    const bf16* pb0 = (lo4 ? Q : V) + boff; const bf16* pb1 = GS + boff;
    u32x2 rl[3]; bf16x8 rb0[3], rb1[3];
#define HG_LOAD(j, s_) do { rl[j] = *(const u32x2*)(plf + (size_t)(s_) * 16 * D); if (FULL || !lo4) rb0[j] = *(const bf16x8*)(pb0 + (size_t)(s_) * 16 * D); if (FULL && lo4) rb1[j] = *(const bf16x8*)(pb1 + (size_t)(s_) * 16 * D); } while (0)
#define HG_WRITE(j, slot) do { char* rb = lds + RAW_OFF + (slot) * RAW_SLOT; *(u32x2*)(rb + tid * 8) = rl[j]; \
        if (lo4) { if (FULL) { *(bf16x8*)(rb + 8192 + t2 * 16) = rb0[j]; *(bf16x8*)(rb + 16384 + t2 * 16) = rb1[j]; } } else *(bf16x8*)(rb + 12288 + t2 * 16) = rb0[j]; } while (0)
    const float gn = FULL ? gain[16 * w + kc] : 0.f;
    s16x4 vf_cur, vf_nxt; u32x2 gv_cur = {0u, 0u}, gv_nxt = {0u, 0u}, gv_prev = {0u, 0u}; f32x4 o_prev = {0.f, 0.f, 0.f, 0.f};
    HG_LOAD(0, 0); if (1 < nsteps) HG_LOAD(1, 1); if (2 < nsteps) HG_LOAD(2, 2);
    HG_WRITE(0, 0); if (1 < nsteps) HG_WRITE(1, 1);
    if (3 < nsteps) HG_LOAD(0, 3); if (4 < nsteps) HG_LOAD(1, 4);
    LDS_WAIT(); __builtin_amdgcn_s_barrier(); asm volatile("" ::: "memory");
    hgrn_prep<FULL>(lds, 0, w, kc, tq, kpos, gsum, vf_cur, gv_cur);
    LDS_WAIT(); __builtin_amdgcn_s_barrier(); asm volatile("" ::: "memory");
#define HG_STEP(j) do { const int s = s3 + (j); if (s < nsteps) { f32x4 o_s; \
        hgrn_mma<FULL>(lds, s, w, kc, tq, vf_cur, S, o_s); \
        if (s + 1 < nsteps) hgrn_prep<FULL>(lds, s + 1, w, kc, tq, kpos, gsum, vf_nxt, gv_nxt); \
        if (FULL && s >= 1) hgrn_fin(lds, s - 1, w, kc, tq, ch, row0, gn, o_prev, gv_prev, O); \
        if (s + 2 < nsteps) HG_WRITE(((j) + 2) % 3, s & 1); \
        if (s + 5 < nsteps) HG_LOAD(((j) + 2) % 3, s + 5); \
        LDS_WAIT(); __builtin_amdgcn_s_barrier(); asm volatile("" ::: "memory"); \
        o_prev = o_s; gv_prev = gv_cur; vf_cur = vf_nxt; gv_cur = gv_nxt; } } while (0)
#pragma unroll 1
    for (int s3 = 0; s3 < nsteps; s3 += 3) { HG_STEP(0); HG_STEP(1); HG_STEP(2); }
    if (FULL) hgrn_fin(lds, nsteps - 1, w, kc, tq, ch, row0, gn, o_prev, gv_prev, O);
    if (Sout) {
#pragma unroll
        for (int kb = 0; kb < 8; ++kb)
#pragma unroll
            for (int i = 0; i < 4; ++i) { const size_t so = (size_t)(16 * kb + 4 * tq + i) * 128 + 16 * w + kc; if (SBF) ((bf16*)Sout)[so] = (bf16)(cvt_pk_bf16(S[kb][i], 0.f) & 0xffffu); else ((float*)Sout)[so] = S[kb][i]; } }
    if (!FULL && Dout && tq == 0) Dout[16 * w + kc] = __builtin_amdgcn_exp2f(gsum);
    LDS_WAIT(); __builtin_amdgcn_s_barrier(); asm volatile("" ::: "memory");
#undef HG_LOAD
#undef HG_WRITE
#undef HG_STEP
}
__device__ __forceinline__ void hgrn_prep64(char* lds, int s, int w, int kc, int tq, float& gsum, bf16x8 (&vf)[2]) {
    const int buf = s & 1; const char* raw = lds + buf * 49152; char* KDT = lds + 98304 + buf * 16384; float* DL = (float*)(lds + 131072 + buf * 512);
    const int ch = 16 * w + kc;
    float lf[2][8];
#pragma unroll
    for (int hf = 0; hf < 2; ++hf)
#pragma unroll
        for (int jj = 0; jj < 8; ++jj) { const int t = 32 * hf + 8 * tq + jj; lf[hf][jj] = h2f(*(const unsigned short*)(raw + (t * 128 + ch) * 2));
            vf[hf][jj] = (short)*(const unsigned short*)(raw + 32768 + (t * 128 + ch) * 2); }
    float c[2][8];
#pragma unroll
    for (int hf = 0; hf < 2; ++hf) { c[hf][0] = lf[hf][0];
#pragma unroll
        for (int jj = 1; jj < 8; ++jj) c[hf][jj] = c[hf][jj - 1] + lf[hf][jj]; }
    const float R0 = c[0][7], R1 = c[1][7];
    float P0, T0, p1_, t1_; row_prefix4(R0, tq, P0, T0); row_prefix4(R1, tq, p1_, t1_);
    const float P1 = T0 + p1_, glast = T0 + t1_;
#pragma unroll
    for (int hf = 0; hf < 2; ++hf) { const float P = hf ? P1 : P0; float kd[8];
#pragma unroll
        for (int jj = 0; jj < 8; ++jj) kd[jj] = (1.f - __builtin_amdgcn_exp2f(lf[hf][jj])) * __builtin_amdgcn_exp2f(glast - (P + c[hf][jj]));
        u32x4 kw; kw.x = cvt_pk_bf16(kd[0], kd[1]); kw.y = cvt_pk_bf16(kd[2], kd[3]); kw.z = cvt_pk_bf16(kd[4], kd[5]); kw.w = cvt_pk_bf16(kd[6], kd[7]);
        *(u32x4*)(KDT + ch * 128 + (((4 * hf + tq) ^ (ch & 7)) << 4)) = kw; }
    DL[ch] = __builtin_amdgcn_exp2f(glast);
    gsum += glast;
}
__device__ __forceinline__ void hgrn_mma64(char* lds, int s, int kc, int tq, const bf16x8 (&vf)[2], f32x4 (&S)[8]) {
    const int buf = s & 1; const char* KDT = lds + 98304 + buf * 16384; const float* DL = (const float*)(lds + 131072 + buf * 512);
#pragma unroll
    for (int kb = 0; kb < 8; ++kb) { const f32x4 dlv = *(const f32x4*)(DL + 16 * kb + 4 * tq); const int kr = 16 * kb + kc;
        const bf16x8 k0 = *(const bf16x8*)(KDT + kr * 128 + ((tq ^ (kr & 7)) << 4)), k1 = *(const bf16x8*)(KDT + kr * 128 + (((4 + tq) ^ (kr & 7)) << 4));
        f32x4 acc = S[kb] * dlv;
        acc = __builtin_amdgcn_mfma_f32_16x16x32_bf16(k0, vf[0], acc, 0, 0, 0);
        S[kb] = __builtin_amdgcn_mfma_f32_16x16x32_bf16(k1, vf[1], acc, 0, 0, 0); }
}
__device__ __forceinline__ void hgrn_state_item64(const float* __restrict__ LOGF, const bf16* __restrict__ V, int row0, int nsteps, int h, bf16* __restrict__ Sout, float* __restrict__ Dout, char* lds) {
    const int tid = opaque_tid(), w = __builtin_amdgcn_readfirstlane(tid >> 6), lane = tid & 63, kc = lane & 15, tq = lane >> 4;
    f32x4 S[8];
#pragma unroll
    for (int kb = 0; kb < 8; ++kb) S[kb] = (f32x4){0.f, 0.f, 0.f, 0.f};
    float gsum = 0.f;
    const char* glf = (const char*)((const unsigned short*)LOGF + (size_t)(row0 + 8 * w + (lane >> 4)) * D + h * 128 + 8 * (lane & 15));
    const char* gv = (const char*)(V + (size_t)(row0 + 8 * w + (lane >> 4)) * D + h * 128 + 8 * (lane & 15));
    LAS char* ll = (LAS char*)lds;
#define HG_DMA(s_, slot) do { _Pragma("unroll") for (int i = 0; i < 2; ++i) \
        __builtin_amdgcn_global_load_lds((const unsigned*)(glf + ((size_t)(s_) * 64 + 4 * i) * (D * 2)), (LAS unsigned*)(ll + (slot) * 49152 + (8 * w + 4 * i) * 256), 16, 0, 0); \
      _Pragma("unroll") for (int i = 0; i < 2; ++i) \
        __builtin_amdgcn_global_load_lds((const unsigned*)(gv + ((size_t)(s_) * 64 + 4 * i) * (D * 2)), (LAS unsigned*)(ll + (slot) * 49152 + 32768 + (8 * w + 4 * i) * 256), 16, 0, 0); } while (0)
    bf16x8 vf_cur[2], vf_nxt[2];
    HG_DMA(0, 0); if (1 < nsteps) HG_DMA(1, 1);
    asm volatile("s_waitcnt vmcnt(0)" ::: "memory"); __builtin_amdgcn_s_barrier(); asm volatile("" ::: "memory");
    hgrn_prep64(lds, 0, w, kc, tq, gsum, vf_cur);
    LDS_WAIT(); __builtin_amdgcn_s_barrier(); asm volatile("" ::: "memory");
#pragma unroll 1
    for (int s = 0; s < nsteps; ++s) {
        if (s + 2 < nsteps) HG_DMA(s + 2, s & 1);
        hgrn_mma64(lds, s, kc, tq, vf_cur, S);
        if (s + 1 < nsteps) hgrn_prep64(lds, s + 1, w, kc, tq, gsum, vf_nxt);
        asm volatile("s_waitcnt vmcnt(0) lgkmcnt(0)" ::: "memory"); __builtin_amdgcn_s_barrier(); asm volatile("" ::: "memory");
        vf_cur[0] = vf_nxt[0]; vf_cur[1] = vf_nxt[1];
    }
#undef HG_DMA
#pragma unroll
    for (int kb = 0; kb < 8; ++kb)
#pragma unroll
        for (int i = 0; i < 4; ++i) Sout[(size_t)(16 * kb + 4 * tq + i) * 128 + 16 * w + kc] = (bf16)(cvt_pk_bf16(S[kb][i], 0.f) & 0xffffu);
    if (tq == 0) Dout[16 * w + kc] = __builtin_amdgcn_exp2f(gsum);
    LDS_WAIT(); __builtin_amdgcn_s_barrier(); asm volatile("" ::: "memory");
}
}

__device__ __forceinline__ float row_scale_any(const float* ssq, const float* ssqS, int row) { return row < MP ? pg8::row_scale(ssq, row) : sk::row_scale_s(ssqS, row - MP); }
__device__ __forceinline__ f32x4 ldx4(const bf16* p) { const u32x2 w = *(const u32x2*)p; return (f32x4){__uint_as_float(w.x << 16), __uint_as_float(w.x & 0xffff0000u), __uint_as_float(w.y << 16), __uint_as_float(w.y & 0xffff0000u)}; }
template <int W>
__device__ __forceinline__ void pool_tile(const bf16* __restrict__ X, const float* __restrict__ ssq, const float* __restrict__ ssqS, const float* __restrict__ gain, const float* __restrict__ hist, int histmode,
                                          int xrow0, int nt, int pos0, bf16* __restrict__ P, float* __restrict__ newpool, int np_first, int c4) {
    const f32x4 gv = *(const f32x4*)(gain + c4);
    f32x4 ring[16], wsum = {0.f, 0.f, 0.f, 0.f};
#pragma unroll
    for (int i = 0; i < 16; ++i) ring[i] = (f32x4){0.f, 0.f, 0.f, 0.f};
#pragma unroll
    for (int i = 1; i < 16; ++i) { const int r = -16 + i; f32x4 val = {0.f, 0.f, 0.f, 0.f};
        if (histmode == 0) { const int row = xrow0 + r; const float rs = row_scale_any(ssq, ssqS, row); val = ldx4(X + (size_t)row * D + c4) * rs * gv; }
        else if (histmode == 2) val = *(const f32x4*)(hist + (size_t)(r + 15) * D + c4);
        wsum += val - ring[(i - W + 16) & 15]; ring[i] = val; }
    for (int blk = 0; blk < nt / 16; ++blk) {
#pragma unroll
        for (int i = 0; i < 16; ++i) { const int r = 16 * blk + i, row = xrow0 + r; const float rs = row_scale_any(ssq, ssqS, row);
            const f32x4 val = ldx4(X + (size_t)row * D + c4) * rs * gv;
            wsum += val - ring[(i - W + 16) & 15]; ring[i] = val;
            const int cnt = (pos0 + r + 1) < W ? (pos0 + r + 1) : W; const float ic = 1.0f / (float)cnt;
            const f32x4 pv = wsum * ic - val;
            u32x2 pw; pw.x = cvt_pk_bf16(pv[0], pv[1]); pw.y = cvt_pk_bf16(pv[2], pv[3]);
            *(u32x2*)(P + (size_t)row * D + c4) = pw;
            if (newpool && r >= np_first) *(f32x4*)(newpool + (size_t)(r - np_first) * D + c4) = val; }
    }
}

#define XB_TMO      128
#define XB_XCNT(j)  (256  + 64 * (j))
#define XB_XSUB(j)  (1280 + 64 * (j))
#define XB_XGEN(j)  (2304 + 64 * (j))
#define XB_TOP      3328
#define XB_TOPGEN   3392
#define XCD_BAR_WORDS 3456
#define XB_SPIN_CAP (1u << 18)
__device__ __forceinline__ unsigned xb_ld(unsigned* p)              { return __hip_atomic_load(p, __ATOMIC_RELAXED, __HIP_MEMORY_SCOPE_AGENT); }
__device__ __forceinline__ unsigned xb_add(unsigned* p, unsigned v) { return __hip_atomic_fetch_add(p, v, __ATOMIC_RELAXED, __HIP_MEMORY_SCOPE_AGENT); }
__device__ __forceinline__ unsigned xb_xcc_id() { return (unsigned)__builtin_amdgcn_s_getreg((3 << 11) | 20) & 0xFu; }
#define XB_SPIN(cond, bar) do { unsigned _sp = 0; while (cond) { __builtin_amdgcn_s_sleep(1); \
    if ((++_sp & 255u) == 0u) { if (xb_ld(&(bar)[XB_TMO])) break; if (_sp > XB_SPIN_CAP) { atomicAdd(&(bar)[XB_TMO], 1u); break; } } } } while (0)
struct XcdBarrier { unsigned* bar; unsigned x; volatile LAS unsigned* st; };
__device__ __forceinline__ XcdBarrier xcd_barrier_post(unsigned* bar, volatile LAS unsigned* st) {
    XcdBarrier b; b.bar = bar; b.x = xb_xcc_id(); b.st = st;
    if (threadIdx.x == 0) (void)xb_add(&bar[XB_XCNT(b.x)], 1u);
    return b;
}
__device__ __forceinline__ void xcd_barrier_complete(unsigned* bar, unsigned x, unsigned& nloc, unsigned& nx) {
    const unsigned G = gridDim.x * gridDim.y * gridDim.z;
    unsigned sum, cnt, mine, sp = 0u;
    for (;;) {
        sum = 0u; cnt = 0u; mine = 0u;
#pragma unroll
        for (unsigned j = 0; j < 16; ++j) { const unsigned c = xb_ld(&bar[XB_XCNT(j)]); sum += c; cnt += (c > 0u) ? 1u : 0u; mine = (j == x) ? c : mine; }
        if (sum == G) break;
        __builtin_amdgcn_s_sleep(1);
        if ((++sp & 255u) == 0u) { if (xb_ld(&bar[XB_TMO])) break; if (sp > XB_SPIN_CAP) { atomicAdd(&bar[XB_TMO], 1u); break; } }
    }
    nloc = mine > 0u ? mine : 1u; nx = cnt > 0u ? cnt : 1u;
}
__device__ __forceinline__ void xcd_barrier(const XcdBarrier& b) {
    asm volatile("s_waitcnt vmcnt(0)" ::: "memory");
    __syncthreads();
    if (threadIdx.x == 0) {
        unsigned* bar = b.bar;
        __builtin_amdgcn_s_waitcnt(0);
        unsigned nloc = b.st[0], nx = b.st[1];
        if (nloc == 0u) { xcd_barrier_complete(bar, b.x, nloc, nx); b.st[0] = nloc; b.st[1] = nx; }
        const unsigned old = xb_add(&bar[XB_XSUB(b.x)], 1u);
        const unsigned gen = old / nloc;
        if (old + 1u == (gen + 1u) * nloc) {
            __builtin_amdgcn_fence(__ATOMIC_RELEASE, "agent");
            asm volatile("s_waitcnt vmcnt(0)" ::: "memory");
            const unsigned og = xb_add(&bar[XB_TOP], 1u);
            const unsigned tg = og / nx;
            if (og + 1u == (tg + 1u) * nx) xb_add(&bar[XB_TOPGEN], 1u);
            else XB_SPIN(xb_ld(&bar[XB_TOPGEN]) == tg, bar);
            __builtin_amdgcn_fence(__ATOMIC_ACQUIRE, "agent");
            xb_add(&bar[XB_XGEN(b.x)], 1u);
            asm volatile("s_waitcnt vmcnt(0)" ::: "memory");
        } else {
            XB_SPIN(xb_ld(&bar[XB_XGEN(b.x)]) == gen, bar);
            __builtin_amdgcn_fence(__ATOMIC_ACQUIRE, "agent");
            asm volatile("s_waitcnt vmcnt(0)" ::: "memory");
        }
    }
    __syncthreads();
}

struct Args { const float* in[31]; float* out; unsigned char* ws; int lo, hi; };
enum { I_XP = 0, I_XS, I_SHG, I_SPL, I_CK, I_CV, I_NMIX, I_NFFN, I_NFIN, I_HWQ, I_HWF, I_HWI, I_HWG, I_HWO, I_HLB, I_HGAIN, I_PW, I_PSC, I_AWQ, I_AWK, I_AWV, I_AWO,
       I_LQ1, I_LK1, I_LQ2, I_LK2, I_SUBG, I_REL, I_FG, I_FU, I_FD };
constexpr int PH_END = 42;

__device__ __forceinline__ void cvt_item(const float* __restrict__ W, int N, bf16* __restrict__ WT, int K, int k0, int n0, int drow, const float* __restrict__ gain, LAS float* scr, int lane) {
    const int sub = lane >> 3, ch = lane & 7;
    f32x4 v[8];
#pragma unroll
    for (int i = 0; i < 8; ++i) v[i] = *(const f32x4*)(W + (size_t)(k0 + 8 * i + sub) * N + n0 + 4 * ch);
#pragma unroll
    for (int i = 0; i < 8; ++i) { const int kk = 8 * i + sub; const float gm = gain ? gain[k0 + kk] : 1.f; LAS float* d = scr + kk * 33 + 4 * ch;
        d[0] = v[i][0] * gm; d[1] = v[i][1] * gm; d[2] = v[i][2] * gm; d[3] = v[i][3] * gm; }
    LDS_WAIT(); asm volatile("" ::: "memory");
    const int c = lane & 7;
#pragma unroll
    for (int j = 0; j < 4; ++j) { const int n = (lane >> 3) + 8 * j; const LAS float* s = scr + (8 * c) * 33 + n;
        u32x4 o; o.x = cvt_pk_bf16(s[0 * 33], s[1 * 33]); o.y = cvt_pk_bf16(s[2 * 33], s[3 * 33]); o.z = cvt_pk_bf16(s[4 * 33], s[5 * 33]); o.w = cvt_pk_bf16(s[6 * 33], s[7 * 33]);
        *(u32x4*)(WT + (size_t)(drow + n) * K + k0 + 8 * c) = o; }
    LDS_WAIT(); asm volatile("" ::: "memory");
}
__device__ __forceinline__ void cvt_matrix(const float* W, int K, int N, bf16* WT, int mode, int row_off, const float* gain, LAS float* scr, int gw, int ngw, int lane) {
    const int nblk = N / 32, items = (K / 64) * nblk;
    for (int it = gw; it < items; it += ngw) { const int kb = it / nblk, nb = it % nblk, n0 = 32 * nb;
        const int drow = mode ? ((n0 >> 7) * 256 + row_off + (n0 & 127)) : (row_off + n0);
        cvt_item(W, N, WT, K, 64 * kb, n0, drow, gain, scr, lane); }
}
__device__ __forceinline__ int rel_bucket(int rel) {
    const int n = rel < 0 ? -rel : rel; int v;
    if (n < 8) v = n; else if (n < 12) v = 8; else if (n < 16) v = 9; else if (n < 23) v = 10; else if (n < 32) v = 11; else if (n < 46) v = 12; else if (n < 64) v = 13; else if (n < 91) v = 14; else v = 15;
    return (rel > 0 ? 16 : 0) + v;
}

typedef const __attribute__((address_space(4))) Args* CArgsP;
__global__ void __launch_bounds__(512, 2) fwd_kernel(Args a) {
    extern __shared__ __attribute__((aligned(16))) unsigned char lds_raw[];
    LAS unsigned char* lds = (LAS unsigned char*)lds_raw;
    char* ldsg = (char*)lds_raw;
    volatile LAS unsigned* MISC = (volatile LAS unsigned*)(lds + MISC_OFF);
    const int tid = threadIdx.x, lane = tid & 63, wave = __builtin_amdgcn_readfirstlane(tid >> 6);
    const int G0 = gridDim.x; const int vcu0 = (G0 % 8 == 0) ? ((int)blockIdx.x % 8) * (G0 / 8) + (int)blockIdx.x / 8 : (int)blockIdx.x;
    unsigned* ctl = (unsigned*)(a.ws + WS_CTL);
    if (tid < 32) MISC[tid] = 0u;
    __syncthreads();
    XcdBarrier bar = xcd_barrier_post(ctl + CW_BAR, MISC + 8);
    const int lo = a.lo, hi = a.hi;
#ifndef SITE_MASK
#define SITE_MASK 0xFFFFFFFFu
#endif
#define SITE(k) (((SITE_MASK) >> (k)) & 1u)
#define PHASE_ON(id) (lo <= (id) && (id) < hi)
#define PHASE_SYNC(id) do { if ((id) != lo) xcd_barrier(bar); } while (0)
#define PH_PTRS CArgsP ap = (CArgsP)__builtin_amdgcn_kernarg_segment_ptr(); asm volatile("" : "+s"(ap)); unsigned char* ws = ap->ws; float* out = ap->out; float* SSQ = (float*)(ws + WS_SSQ); float* CONSTS = (float*)(ws + WS_CONST); \
    float* X = (float*)(ws + WS_X); bf16* XB = (bf16*)(ws + WS_XB); bf16* A0 = (bf16*)(ws + WS_A0); bf16* A2 = (bf16*)(ws + WS_A2); bf16* A3 = (bf16*)(ws + WS_A3); bf16* A4 = (bf16*)(ws + WS_A4); \
    float* ssq_mix = SSQ + (size_t)(2 * layer) * M * 8; float* ssq_ffn = SSQ + (size_t)(2 * layer + 1) * M * 8; float* ssq_next = SSQ + (size_t)(2 * layer + 2) * M * 8; \
    float* SSQS = (float*)(ws + WS_SSQS); float* sq_mix = SSQS + (size_t)(2 * layer) * 16384; float* sq_ffn = SSQS + (size_t)(2 * layer + 1) * 16384; float* sq_next = SSQS + (size_t)(2 * layer + 2) * 16384; (void)sq_mix; (void)sq_ffn; (void)sq_next; \
    (void)out; (void)CONSTS; (void)X; (void)XB; (void)A0; (void)A2; (void)A3; (void)A4; (void)ssq_mix; (void)ssq_ffn; (void)ssq_next; \
    int G = G0, vcu = vcu0, bx = (int)blockIdx.x; asm volatile("" : "+s"(G), "+s"(vcu), "+s"(bx)); (void)bx; \
    const int tid = opaque_tid(), lane = tid & 63, wave = __builtin_amdgcn_readfirstlane(tid >> 6), gw = vcu * 8 + wave, ngw = G * 8; (void)lane; (void)gw; (void)ngw;

    if (SITE(0) && PHASE_ON(0)) { const int layer = 0; PH_PTRS
        LAS float* scr = (LAS float*)(lds + wave * 16384);
#pragma unroll 1
        for (int j = 0; j < 2; ++j) { const float* gmix = ap->in[I_NMIX] + (size_t)(3 * j) * D; bf16* wt = (bf16*)(ws + WS_HG0 + j * HG_STRIDE); const size_t wo = (size_t)j * D * D;
            cvt_matrix(ap->in[I_HWQ] + wo, D, D, wt, 0, 0, gmix, scr, gw, ngw, lane);
            cvt_matrix(ap->in[I_HWF] + wo, D, D, wt, 0, 2048, gmix, scr, gw, ngw, lane);
            cvt_matrix(ap->in[I_HWI] + wo, D, D, wt, 0, 4096, gmix, scr, gw, ngw, lane);
            cvt_matrix(ap->in[I_HWG] + wo, D, D, wt, 0, 6144, gmix, scr, gw, ngw, lane);
            cvt_matrix(ap->in[I_HWO] + wo, D, D, wt + (size_t)NHG * D, 0, 0, nullptr, scr, gw, ngw, lane); }
        { const float* gmix = ap->in[I_NMIX] + (size_t)2 * D; bf16* wt = (bf16*)(ws + WS_QKV);
            cvt_matrix(ap->in[I_AWQ], D, D, wt, 0, 0, gmix, scr, gw, ngw, lane);
            cvt_matrix(ap->in[I_AWK], D, D, wt, 0, 2048, gmix, scr, gw, ngw, lane);
            cvt_matrix(ap->in[I_AWV], D, D, wt, 0, 4096, gmix, scr, gw, ngw, lane);
            cvt_matrix(ap->in[I_AWO], D, D, (bf16*)(ws + WS_WOA), 0, 0, nullptr, scr, gw, ngw, lane); }
#pragma unroll 1
        for (int g4 = 0; g4 < 4; ++g4) cvt_matrix(ap->in[I_PW] + (size_t)g4 * 512 * 512, 512, 512, (bf16*)(ws + WS_WP), 0, g4 * 512, nullptr, scr, gw, ngw, lane);
#pragma unroll 1
        for (int i = 0; i < 4; ++i) { const float* gf = ap->in[I_NFFN] + (size_t)i * D; bf16* w1 = (bf16*)(ws + WS_W1 + i * FFN_STRIDE); bf16* w2 = (bf16*)(ws + WS_W1 + i * FFN_STRIDE + W2_OFF);
            cvt_matrix(ap->in[I_FG] + (size_t)i * D * FF, D, FF, w1, 1, 0, gf, scr, gw, ngw, lane);
            cvt_matrix(ap->in[I_FU] + (size_t)i * D * FF, D, FF, w1, 1, 128, gf, scr, gw, ngw, lane);
            cvt_matrix(ap->in[I_FD] + (size_t)i * FF * D, FF, D, w2, 0, 0, nullptr, scr, gw, ngw, lane); }
        for (int m = gw; m < M; m += ngw) { const float* src = m < MP ? ap->in[I_XP] + (size_t)m * D : ap->in[I_XS] + (size_t)(m - MP) * D; float s = 0.f;
#pragma unroll
            for (int j = 0; j < 4; ++j) { const int c = j * 512 + lane * 8; f32x4 v0 = *(const f32x4*)(src + c), v1 = *(const f32x4*)(src + c + 4);
                const u32x4 w = pg8::pack8(v0, v1); *(u32x4*)(XB + (size_t)m * D + c) = w; pg8::unpack8(w, v0, v1);
                s += (v0[0] * v0[0] + v0[1] * v0[1]) + (v0[2] * v0[2] + v0[3] * v0[3]) + (v1[0] * v1[0] + v1[1] * v1[1]) + (v1[2] * v1[2] + v1[3] * v1[3]); }
            s = wave_sum(s); if (m < MP) { if (lane < 8) SSQ[(size_t)m * 8 + lane] = lane == 0 ? s : 0.f; } else SSQS[(size_t)(m - MP) * 64 + lane] = lane == 0 ? s : 0.f; }
        if (bx == 0) {
            for (int c = tid; c < D; c += 512) { const float l0 = ap->in[I_HLB][c], l1 = ap->in[I_HLB][D + c]; CONSTS[c] = 0.f; CONSTS[D + c] = 1.f / (1.f + __expf(l0 - l1)); }
            for (int e = tid; e < 2048; e += 512) { const int hh = e >> 8, idx = e & 255, rel = idx - 192;
                CONSTS[4608 + e] = (ap->in[I_REL][rel_bucket(rel) * 8 + hh] - ap->in[I_REL][15 * 8 + hh]) * (1.0f / ATT_SCALE); }
            if (wave == 0) { float s1 = 0.f, s2 = 0.f;
                for (int c = lane; c < 128; c += 64) { s1 += ap->in[I_LQ1][c] * ap->in[I_LK1][c]; s2 += ap->in[I_LQ2][c] * ap->in[I_LK2][c]; }
                s1 = wave_sum(s1); s2 = wave_sum(s2); if (lane == 0) CONSTS[4096] = __expf(s1) - __expf(s2) + LAMBDA_INIT; }
        }
    }

#pragma unroll 1
    for (int layer = 0; layer < 4; ++layer) {
        const int base = 1 + 10 * layer, mix = layer % 3;
        if (mix == 0) {
            const int j = layer / 3;
#define HG_PTRS PH_PTRS const bf16* whg = (const bf16*)(ws + WS_HG0 + j * HG_STRIDE); const bf16* who = whg + (size_t)NHG * D; \
            float* LOGF = (float*)(ws + WS_A1); bf16* SB = (bf16*)(ws + WS_SB); float* DT = (float*)(ws + WS_DT); (void)whg; (void)who; (void)LOGF; (void)SB; (void)DT;
            if (SITE(1) && PHASE_ON(base + 0)) { PHASE_SYNC(base + 0); HG_PTRS
                pg8::Gemm g{XB, whg, MP, NHG, D, D, D, 0}; pg8::StaticOrder S; S.init(MP, NHG, G, bx);
                pg8::EpiHgrn E{A0, LOGF, A2, A3, ssq_mix, CONSTS + j * D};
                pg8::gemm_phase<pg8::EpiHgrn, pg8::StaticOrder, true, true>(lds, g, S, E);
                sk::SkHgrn ES{A0, LOGF, sq_mix, CONSTS + j * D}; sk::skinny_phase<sk::SkHgrn, 2>(XB + (size_t)MP * D, D, 0, whg, D, D, NHG / 32, vcu, G, ES, (LAS float*)(lds + 131072), lds); }
            if (SITE(2) && PHASE_ON(base + 1)) { PHASE_SYNC(base + 1); HG_PTRS
                for (int it = vcu; it < 256; it += G) { const int h = it & 15, c = it >> 4;
                    hg::hgrn_state_item64(LOGF, A2, c * 1024, 16, h, SB + (size_t)(h * 16 + c) * 16384, DT + (size_t)(h * 16 + c) * 128, ldsg); } }
            if (SITE(3) && PHASE_ON(base + 2)) { PHASE_SYNC(base + 2); HG_PTRS
                for (int e = vcu * 512 + tid; e < 16 * 8192; e += G * 512) { const int h = e >> 13, k = (e & 8191) >> 6, v2 = (e & 63) * 2;
                    f32x2 s = {0.f, 0.f}; bf16* p = SB + ((size_t)h * 16 * 128 + k) * 128 + v2; const float* dp = DT + (size_t)h * 16 * 128 + k;
#pragma unroll 8
                    for (int c = 0; c < 16; ++c) { const unsigned bw = *(const unsigned*)(p + (size_t)c * 16384); const f32x2 bb = {__uint_as_float(bw << 16), __uint_as_float(bw & 0xffff0000u)}; const float d = dp[c * 128];
                        *(unsigned*)(p + (size_t)c * 16384) = cvt_pk_bf16(s[0], s[1]); s = s * d + bb; }
                    *(f32x2*)(out + OFF_HG_P + ((size_t)(j * 16 + h) * 128 + k) * 128 + v2) = s; } }
            if (SITE(4) && PHASE_ON(base + 3)) { PHASE_SYNC(base + 3); HG_PTRS
                const float* gain = ap->in[I_HGAIN] + j * 128;
                for (int it = vcu; it < 256; it += G) { const int h = it & 15, c = it >> 4;
                    hg::hgrn_item<true, true>(A0, LOGF, A2, A3, A4, c * 1024, 64, h, SB + (size_t)(h * 16 + c) * 16384, nullptr, nullptr, gain, ldsg); }
                for (int u = vcu; u < 256; u += G) { const int b = u >> 4, h = u & 15; const size_t so = ((size_t)(j * 16 + b) * 16 + h) * 16384;
                    hg::hgrn_item<true, false>(A0, LOGF, A2, A3, A4, MP + b * 16, 1, h, ap->in[I_SHG] + so, out + OFF_HG_S + so, nullptr, gain, ldsg); } }
            if (SITE(5) && PHASE_ON(base + 4)) { PHASE_SYNC(base + 4); HG_PTRS
                pg8::Gemm g{A4, who, MP, D, D, D, D, 0}; pg8::StaticOrder S; S.init(MP, D, G, bx);
                pg8::EpiResid E{X, XB, ssq_ffn, nullptr, (LAS float*)(lds + 131072)};
                pg8::gemm_phase<pg8::EpiResid, pg8::StaticOrder, true, true>(lds, g, S, E);
                sk::SkResid ES{X, XB, sq_ffn, nullptr}; sk::skinny_phase<sk::SkResid, 1>(A4 + (size_t)MP * D, D, 0, who, D, D, D / 32, vcu, G, ES, (LAS float*)(lds + 131072), lds); }
        } else if (mix == 1) {
            if (SITE(6) && PHASE_ON(base + 0)) { PHASE_SYNC(base + 0); PH_PTRS
                const float* gain = ap->in[I_NMIX] + (size_t)layer * D; const int c4 = tid * 4, grp = tid >> 7;
                for (int t = vcu; t < 256 + 16; t += G) {
                    int xrow0, nt, pos0, hm, npf; const float* hist = nullptr; float* np = nullptr;
                    if (t < 256) { xrow0 = 64 * t; nt = 64; pos0 = 64 * t; hm = t == 0 ? 1 : 0; npf = 49; if (t == 255) np = out + OFF_PL_P; }
                    else { const int b = t - 256; xrow0 = MP + 16 * b; nt = 16; pos0 = 4096; hm = 2; hist = ap->in[I_SPL] + (size_t)b * 15 * D; npf = 1; np = out + OFF_PL_S + (size_t)b * 15 * D; }
                    if (grp == 0) pool_tile<2>(XB, ssq_mix, sq_mix, gain, hist, hm, xrow0, nt, pos0, A0, np, npf, c4);
                    else if (grp == 1) pool_tile<4>(XB, ssq_mix, sq_mix, gain, hist, hm, xrow0, nt, pos0, A0, np, npf, c4);
                    else if (grp == 2) pool_tile<8>(XB, ssq_mix, sq_mix, gain, hist, hm, xrow0, nt, pos0, A0, np, npf, c4);
                    else pool_tile<16>(XB, ssq_mix, sq_mix, gain, hist, hm, xrow0, nt, pos0, A0, np, npf, c4); } }
            if (SITE(7) && PHASE_ON(base + 4)) { PHASE_SYNC(base + 4); PH_PTRS
                pg8::Gemm g{A0, (const bf16*)(ws + WS_WP), MP, D, 512, D, 512, 512}; pg8::StaticOrder S; S.init(MP, D, G, bx);
                pg8::EpiResid E{X, XB, ssq_ffn, ap->in[I_PSC], (LAS float*)(lds + 131072)};
                pg8::gemm_phase<pg8::EpiResid, pg8::StaticOrder, true, true>(lds, g, S, E);
                sk::SkResid ES{X, XB, sq_ffn, ap->in[I_PSC]}; sk::skinny_phase<sk::SkResid, 1>(A0 + (size_t)MP * D, D, 512, (const bf16*)(ws + WS_WP), 512, 512, D / 32, vcu, G, ES, (LAS float*)(lds + 131072), lds); }
        } else {
#define AT_PTRS PH_PTRS bf16* Kb = (bf16*)(ws + WS_A1); bf16* Oat = (bf16*)(ws + WS_A1 + 65 * MiB); float* PART = (float*)(ws + WS_PART); (void)Kb; (void)Oat; (void)PART;
            if (SITE(8) && PHASE_ON(base + 0)) { PHASE_SYNC(base + 0); AT_PTRS
                pg8::Gemm g{XB, (const bf16*)(ws + WS_QKV), MP, NQKV, D, D, D, 0}; pg8::StaticOrder S; S.init(MP, NQKV, G, bx);
                pg8::EpiQkv E{A0, Kb, A2, out, ssq_mix};
                pg8::gemm_phase<pg8::EpiQkv, pg8::StaticOrder, true, true>(lds, g, S, E);
                sk::SkQkv ES{A0, out, sq_mix}; sk::skinny_phase<sk::SkQkv, 2>(XB + (size_t)MP * D, D, 0, (const bf16*)(ws + WS_QKV), D, D, NQKV / 32, vcu, G, ES, (LAS float*)(lds + 131072), lds); }
            if (SITE(9) && PHASE_ON(base + 1)) { PHASE_SYNC(base + 1); AT_PTRS
                float* lut = (float*)(ldsg + 131072); float* scr = (float*)(ldsg + 131072 + 8192);
                for (int e = tid; e < 2048; e += 512) lut[e] = CONSTS[4608 + e];
                __syncthreads();
                if (SITE(15)) for (int u = vcu; u < 256; u += G) { const int b = u >> 4, h = (u >> 1) & 7, sp = u & 1;
                    att::attn_sample_unit(b, h, sp, A0, ap->in[I_CK], ap->in[I_CV], out + OFF_K_S, out + OFF_V_S, PART, lut + h * 256, ldsg, scr); __syncthreads(); }
            }
            if (SITE(9) && SITE(16) && PHASE_ON(base + 1)) { AT_PTRS
                float* lut = (float*)(ldsg + 131072); float* scr = (float*)(ldsg + 131072 + 8192);
                __syncthreads();
                for (int e = tid; e < 2048; e += 512) lut[e] = CONSTS[4608 + e];
                __syncthreads();
                for (int p = vcu; p < 1024; p += G) { const int hc = p >> 6, pr = p & 63, h = hc & 7, c = hc >> 3;
#pragma unroll 1
                    for (int which = 0; which < 2; ++which) { const int qb = which ? pr : 127 - pr;
                        att::attn_unit2(A0 + (size_t)qb * 128 * D + h * 256 + c * 128, Kb + h * 256 + c * 128, A2 + h * 256,
                                        A3 + (size_t)c * M * D + (size_t)qb * 128 * D + h * 256, 2 * qb + 2, 2 * qb + ((wave & 3) >> 1), 128 * qb + 32 * (wave & 3), lut + h * 256, ldsg, scr);
                        __syncthreads(); } } }
            if (SITE(10) && PHASE_ON(base + 2)) { PHASE_SYNC(base + 2); AT_PTRS
                const float lam = CONSTS[4096]; const f32x4 sg = *(const f32x4*)(ap->in[I_SUBG] + lane * 4);
                {
                    const f32x4 g0 = *(const f32x4*)(ap->in[I_SUBG] + (lane & 31) * 8), g1 = *(const f32x4*)(ap->in[I_SUBG] + (lane & 31) * 8 + 4);
                    for (int row = gw; row < MP; row += ngw) { const size_t off = (size_t)row * D + lane * 8; u32x4 wa[4], wb[4];
#pragma unroll
                        for (int q = 0; q < 4; ++q) { wa[q] = *(const u32x4*)(A3 + off + q * 512); wb[q] = *(const u32x4*)(A3 + (size_t)M * D + off + q * 512); }
#pragma unroll
                        for (int q = 0; q < 4; ++q) { f32x4 a0, a1, b0, b1; pg8::unpack8(wa[q], a0, a1); pg8::unpack8(wb[q], b0, b1);
                            a0 = a0 - b0 * lam; a1 = a1 - b1 * lam;
                            float ss = (a0[0] * a0[0] + a0[1] * a0[1]) + (a0[2] * a0[2] + a0[3] * a0[3]) + (a1[0] * a1[0] + a1[1] * a1[1]) + (a1[2] * a1[2] + a1[3] * a1[3]);
                            ss = row16_sum(ss); ss += __shfl_xor(ss, 16);
                            const float rs = __builtin_amdgcn_rsqf(ss * (1.f / 256.f) + EPS) * (1.f - LAMBDA_INIT);
                            *(u32x4*)(Oat + off + q * 512) = pg8::pack8(a0 * rs * g0, a1 * rs * g1); } } }
                for (int it = MP * 8 + gw; it < M * 8; it += ngw) { const int row = it >> 3, h = it & 7; f32x4 o;
                    if (row < MP) { const size_t off = (size_t)row * D + h * 256 + lane * 4; const u32x2 w0 = *(const u32x2*)(A3 + off), w1 = *(const u32x2*)(A3 + (size_t)M * D + off);
                        o[0] = __uint_as_float(w0.x << 16) - lam * __uint_as_float(w1.x << 16); o[1] = __uint_as_float(w0.x & 0xffff0000u) - lam * __uint_as_float(w1.x & 0xffff0000u);
                        o[2] = __uint_as_float(w0.y << 16) - lam * __uint_as_float(w1.y << 16); o[3] = __uint_as_float(w0.y & 0xffff0000u) - lam * __uint_as_float(w1.y & 0xffff0000u);
                    } else { const int b = (row - MP) >> 4, t = (row - MP) & 15, vhalf = lane >> 5, col = (lane & 31) * 4; f32x4 oc[2];
#pragma unroll
                        for (int c = 0; c < 2; ++c) { const float* p0 = PART + (size_t)((((b * 8 + h) * 2 + 0) * 4) + c * 2 + vhalf) * 2112; const float* p1 = p0 + 4 * 2112;
                            const float m0 = p0[t], m1 = p1[t], l0 = p0[16 + t], l1 = p1[16 + t], mm = fmaxf(m0, m1);
                            const float w0 = __builtin_amdgcn_exp2f((m0 - mm) * (ATT_SCALE * 1.4426950408889634f)), w1 = __builtin_amdgcn_exp2f((m1 - mm) * (ATT_SCALE * 1.4426950408889634f));
                            const f32x4 o0 = *(const f32x4*)(p0 + 64 + t * 128 + col), o1 = *(const f32x4*)(p1 + 64 + t * 128 + col);
                            oc[c] = (o0 * w0 + o1 * w1) * (1.0f / (l0 * w0 + l1 * w1)); }
                        o = oc[0] - oc[1] * lam; }
                    const float ss = wave_sum((o[0] * o[0] + o[1] * o[1]) + (o[2] * o[2] + o[3] * o[3]));
                    const float rs = __builtin_amdgcn_rsqf(ss * (1.f / 256.f) + EPS) * (1.f - LAMBDA_INIT);
                    o = o * rs * sg; u32x2 w; w.x = cvt_pk_bf16(o[0], o[1]); w.y = cvt_pk_bf16(o[2], o[3]);
                    *(u32x2*)(Oat + (size_t)row * D + h * 256 + lane * 4) = w; } }
            if (SITE(11) && PHASE_ON(base + 4)) { PHASE_SYNC(base + 4); AT_PTRS
                pg8::Gemm g{Oat, (const bf16*)(ws + WS_WOA), MP, D, D, D, D, 0}; pg8::StaticOrder S; S.init(MP, D, G, bx);
                pg8::EpiResid E{X, XB, ssq_ffn, nullptr, (LAS float*)(lds + 131072)};
                pg8::gemm_phase<pg8::EpiResid, pg8::StaticOrder, true, true>(lds, g, S, E);
                sk::SkResid ES{X, XB, sq_ffn, nullptr}; sk::skinny_phase<sk::SkResid, 1>(Oat + (size_t)MP * D, D, 0, (const bf16*)(ws + WS_WOA), D, D, D / 32, vcu, G, ES, (LAS float*)(lds + 131072), lds); }
        }
        if (SITE(12) && PHASE_ON(base + 5)) { PHASE_SYNC(base + 5); PH_PTRS
            const bf16* w1 = (const bf16*)(ws + WS_W1 + layer * FFN_STRIDE); pg8::Gemm g{XB, w1, MP, 2 * FF, D, D, D, 0}; pg8::StaticOrder S; S.init(MP, 2 * FF, G, bx);
            pg8::EpiFfn1 E{A0, ssq_ffn};
            pg8::gemm_phase<pg8::EpiFfn1, pg8::StaticOrder, true, true>(lds, g, S, E);
            sk::SkFfn1 ES{A0, sq_ffn}; sk::skinny_phase<sk::SkFfn1, 2>(XB + (size_t)MP * D, D, 0, w1, D, D, FF / 16, vcu, G, ES, (LAS float*)(lds + 131072), lds); }
        if (SITE(13) && PHASE_ON(base + 6)) { PHASE_SYNC(base + 6); PH_PTRS
            const bf16* w2 = (const bf16*)(ws + WS_W1 + layer * FFN_STRIDE + W2_OFF); pg8::Gemm g{A0, w2, MP, D, FF, FF, FF, 0}; pg8::StaticOrder S; S.init(MP, D, G, bx, 1);
            pg8::EpiResid E{X, XB, ssq_next, nullptr, (LAS float*)(lds + 131072)};
            pg8::gemm_phase<pg8::EpiResid, pg8::StaticOrder, true, true>(lds, g, S, E);
            sk::SkResid ES{X, XB, sq_next, nullptr}; sk::skinny_phase<sk::SkResid, 1>(A0 + (size_t)MP * FF, FF, 0, w2, FF, FF, D / 32, vcu, G, ES, (LAS float*)(lds + 131072), lds); }
    }
    if (SITE(14) && PHASE_ON(41)) { const int layer = 0;
        PHASE_SYNC(41); PH_PTRS
        const float* ssq = SSQ + (size_t)8 * M * 8; const float* gf = ap->in[I_NFIN];
        for (int m = gw; m < M; m += ngw) { const float rs = row_scale_any(ssq, SSQS + (size_t)8 * 16384, m); float* dst = m < MP ? out + OFF_Y_P + (size_t)m * D : out + OFF_Y_S + (size_t)(m - MP) * D;
#pragma unroll
            for (int j = 0; j < 8; ++j) { const int c = j * 256 + lane * 4; *(f32x4*)(dst + c) = ldx4(XB + (size_t)m * D + c) * rs * *(const f32x4*)(gf + c); } } }
}

extern "C" void kernel_launch(void* const* d_in, const int* in_sizes, int n_in, void* d_out, int out_size, void* d_ws, size_t ws_size, hipStream_t stream) {
    static int grid = 0;
    if (grid == 0) {
        if (n_in != 31 || (size_t)out_size != OUT_END || ws_size < WS_END) { fprintf(stderr, "kernel_launch: unexpected shapes: n_in %d out %d ws %zu\n", n_in, out_size, ws_size); grid = -1; return; }
        int dev = 0, cus = 0, per_cu = 0;
        if (hipGetDevice(&dev) != hipSuccess || hipDeviceGetAttribute(&cus, hipDeviceAttributeMultiprocessorCount, dev) != hipSuccess) { grid = -1; return; }
        if (hipFuncSetAttribute((const void*)fwd_kernel, hipFuncAttributeMaxDynamicSharedMemorySize, LDS_BYTES) != hipSuccess) { fprintf(stderr, "kernel_launch: hipFuncSetAttribute failed\n"); grid = -1; return; }
        if (hipOccupancyMaxActiveBlocksPerMultiprocessor(&per_cu, (const void*)fwd_kernel, 512, LDS_BYTES) != hipSuccess || per_cu < 1) { fprintf(stderr, "kernel_launch: occupancy query says %d\n", per_cu); (void)hipGetLastError(); per_cu = 1; }
        grid = cus;
    }
    if (grid < 0) return;
    (void)hipMemsetAsync((char*)d_ws + WS_CTL, 0, CTL_ZERO_BYTES, stream);
    Args a{};
    for (int i = 0; i < 31; ++i) a.in[i] = (const float*)d_in[i];
    a.out = (float*)d_out; a.ws = (unsigned char*)d_ws;
#if MK_ONE_LAUNCH
    a.lo = 0; a.hi = PH_END;
    hipLaunchKernelGGL(fwd_kernel, dim3(grid), dim3(512), LDS_BYTES, stream, a);
#else
    static const int ids[] = {0, 1, 2, 3, 4, 5, 6, 7, 11, 15, 16, 17, 21, 22, 23, 25, 26, 27, 31, 32, 33, 34, 35, 36, 37, 41};
    for (int k = 0; k < (int)(sizeof(ids) / sizeof(ids[0])); ++k) { a.lo = ids[k]; a.hi = ids[k] + 1; hipLaunchKernelGGL(fwd_kernel, dim3(grid), dim3(512), LDS_BYTES, stream, a); }
#endif
    const hipError_t le = hipPeekAtLastError();
    if (le != hipSuccess) fprintf(stderr, "kernel_launch: launch failed: %s\n", hipGetErrorName(le));
}
```

```cpp
#include <hip/hip_runtime.h>
#include <cstdio>
#include <cstdint>

#ifndef MK_ONE_LAUNCH
#define MK_ONE_LAUNCH 1
#endif

#define LAS __attribute__((address_space(3)))
#define GAS __attribute__((address_space(1)))
typedef unsigned short bf16;
typedef short bf16x8 __attribute__((ext_vector_type(8)));
typedef short s16x4 __attribute__((ext_vector_type(4)));
typedef float f32x4 __attribute__((ext_vector_type(4)));
typedef float f32x2 __attribute__((ext_vector_type(2)));
typedef float f32x8 __attribute__((ext_vector_type(8)));
typedef float f32x16 __attribute__((ext_vector_type(16)));
typedef unsigned u32x4 __attribute__((ext_vector_type(4)));
typedef unsigned u32x2 __attribute__((ext_vector_type(2)));

constexpr int D = 2048, MP = 16384, MS = 256, M = MP + MS, FF = 5632, NHG = 8192, NQKV = 6144;
constexpr float EPS = 1e-6f;
constexpr float LAMBDA_INIT = 0.4707130183435842f;
constexpr float ATT_SCALE = 0.088388347648318440f;
constexpr size_t OFF_Y_P = 0, OFF_Y_S = 33554432, OFF_HG_P = 34078720, OFF_HG_S = 34603008, OFF_PL_P = 42991616, OFF_PL_S = 43022336,
                 OFF_K_P = 43513856, OFF_V_P = 77068288, OFF_K_S = 110622720, OFF_V_S = 111147008, OUT_END = 111671296;
constexpr size_t MiB = 1u << 20;
constexpr size_t WS_CTL = 0, CTL_ZERO_BYTES = 64 * 1024;
constexpr size_t WS_CONST = 2 * MiB;
constexpr size_t WS_HG0 = 4 * MiB, HG_STRIDE = 40 * MiB;
constexpr size_t WS_QKV = 84 * MiB, WS_WOA = 108 * MiB, WS_WP = 116 * MiB;
constexpr size_t WS_W1 = 118 * MiB, FFN_STRIDE = 66 * MiB, W2_OFF = 44 * MiB;
constexpr size_t WS_X = 384 * MiB;
constexpr size_t WS_XB = 514 * MiB;
constexpr size_t WS_A0 = 580 * MiB;
constexpr size_t WS_A1 = 645 * MiB;
constexpr size_t WS_A2 = 775 * MiB;
constexpr size_t WS_A3 = 840 * MiB;
constexpr size_t WS_A4 = 905 * MiB;
constexpr size_t WS_SB = 970 * MiB;
constexpr size_t WS_DT = 1034 * MiB;
constexpr size_t WS_PART = 1036 * MiB;
constexpr size_t WS_SSQ = 1048 * MiB;
constexpr size_t WS_SSQS = 1054 * MiB;
constexpr size_t WS_END = 1056 * MiB;
constexpr int CW_TMO = 0, CW_BAR = 4096;
constexpr int LDS_BYTES = 147456, MISC_OFF = 131072 + 8192 + 2048 + 320;

__device__ __forceinline__ unsigned cvt_pk_bf16(float lo, float hi) { unsigned r; asm volatile("v_cvt_pk_bf16_f32 %0, %1, %2" : "=v"(r) : "v"(lo), "v"(hi)); return r; }
__device__ __forceinline__ float bf2f(unsigned short b) { return __uint_as_float(((unsigned)b) << 16); }
typedef _Float16 f16x2 __attribute__((ext_vector_type(2)));
__device__ __forceinline__ unsigned pk_f16(float a, float b) { f16x2 v; v.x = (_Float16)a; v.y = (_Float16)b; return __builtin_bit_cast(unsigned, v); }
__device__ __forceinline__ float h2f(unsigned short u) { return (float)__builtin_bit_cast(_Float16, u); }
__device__ __forceinline__ float wave_sum(float v) {
#pragma unroll
    for (int o = 1; o < 64; o <<= 1) v += __shfl_xor(v, o);
    return v;
}
__device__ __forceinline__ int opaque_tid() { int t = threadIdx.x; asm volatile("" : "+v"(t)); return t; }
__device__ __forceinline__ float row16_sum(float v) {
    v += __builtin_bit_cast(float, __builtin_amdgcn_update_dpp(0, __builtin_bit_cast(int, v), 0x128, 0xf, 0xf, false));
    v += __builtin_bit_cast(float, __builtin_amdgcn_update_dpp(0, __builtin_bit_cast(int, v), 0x124, 0xf, 0xf, false));
    v += __builtin_bit_cast(float, __builtin_amdgcn_update_dpp(0, __builtin_bit_cast(int, v), 0x122, 0xf, 0xf, false));
    v += __builtin_bit_cast(float, __builtin_amdgcn_update_dpp(0, __builtin_bit_cast(int, v), 0x121, 0xf, 0xf, false));
    return v;
}
__device__ __forceinline__ float fast_exp(float x) { return __builtin_amdgcn_exp2f(x * 1.4426950408889634f); }
__device__ __forceinline__ float sigmoidf_(float x) { return __builtin_amdgcn_rcpf(1.0f + fast_exp(-x)); }
__device__ __forceinline__ void sigmoid8(const float (&x)[8], float (&sg)[8]) {
    float e[8];
#define SG8_PIN() asm volatile("" : "+v"(e[0]), "+v"(e[1]), "+v"(e[2]), "+v"(e[3]), "+v"(e[4]), "+v"(e[5]), "+v"(e[6]), "+v"(e[7]))
#pragma unroll
    for (int j = 0; j < 8; ++j) e[j] = x[j] * -1.4426950408889634f;
    SG8_PIN();
#pragma unroll
    for (int j = 0; j < 8; ++j) e[j] = __builtin_amdgcn_exp2f(e[j]);
    SG8_PIN();
#pragma unroll
    for (int j = 0; j < 8; ++j) e[j] = 1.0f + e[j];
    SG8_PIN();
#pragma unroll
    for (int j = 0; j < 8; ++j) e[j] = __builtin_amdgcn_rcpf(e[j]);
    SG8_PIN();
#pragma unroll
    for (int j = 0; j < 8; ++j) sg[j] = e[j];
#undef SG8_PIN
}
#define LDS_WAIT() asm volatile("s_waitcnt lgkmcnt(0)" ::: "memory")
#define VM_WAIT() asm volatile("s_waitcnt vmcnt(0)" ::: "memory")

namespace pg8 {
#define PG8_LAS __attribute__((address_space(3)))
typedef unsigned short bf16_t;
constexpr int BM = 256, BK = 64, HALF = 128, HTB = HALF * BK * 2, STAGE_BYTES = 8 * HTB, NXCD = 8, WGM = 4;
__host__ __device__ __forceinline__ int lds_byte(int r, int c) { const int st = (r >> 4) * 2 + (c >> 5), rr = r & 15, cc = c & 31, ob = rr * 64 + cc * 2; return st * 1024 + (ob ^ (((ob >> 9) & 1) << 5)); }
__host__ __device__ __forceinline__ void stage_rc(int b, int& R, int& C) { const int st = b / 1024, sb = b % 1024, swz = sb ^ (((sb >> 9) & 1) << 5); R = (st >> 1) * 16 + swz / 64; C = (st & 1) * 32 + (swz % 64) / 2; }
__host__ __device__ __forceinline__ int perm32(int rho) { const int n = rho >> 4, i = rho & 15; return 8 * (i >> 2) + 4 * n + (i & 3); }
struct Unit { int pm, pn; };
struct Gemm { const bf16_t* A; const bf16_t* Bt; int M, N, K, lda, ldb, a_koff; };
struct StaticOrder {
    int nM, nN, nwg, G, c, rev;
    __host__ __device__ void init(int M_, int N_, int G_, int c_, int rev_ = 0) { nM = M_ / BM; nN = N_ / BM; nwg = nM * nN; G = G_; c = c_; rev = rev_; }
    __host__ __device__ bool next(int i, Unit& u) const {
        const long L = (long)i * G + c; if (L >= nwg) return false;
        int wgid = (int)L; { const int q = nwg / NXCD, r = nwg % NXCD, xcd = wgid % NXCD, off = wgid / NXCD; wgid = (xcd < r ? xcd * (q + 1) : r * (q + 1) + (xcd - r) * q) + off; }
        const int nig = WGM * nN, gid = wgid / nig, fm = gid * WGM, gsz = (nM - fm) < WGM ? (nM - fm) : WGM;
        u.pm = fm + ((wgid % nig) % gsz); u.pn = (wgid % nig) / gsz; if (rev) u.pm = nM - 1 - u.pm; return true;
    }
    __device__ __forceinline__ void a_ready(const Unit&) const {}
    __device__ __forceinline__ void done(const Unit&) const {}
};

__device__ __forceinline__ float row_scale(const float* ssq, int row);
template <class Epi, class Sched, bool ALIGN_EPI = false, bool SP2 = false>
__device__ __forceinline__ void gemm_phase(PG8_LAS unsigned char* lds, const Gemm g, const Sched& S, const Epi& E) {
    const int tid = opaque_tid(), wid = __builtin_amdgcn_readfirstlane(tid >> 6), lane = tid & 63, wr = wid >> 2, wc = wid & 3, fr = lane & 15, fq = lane >> 4;
    const int K = g.K, nt = K / BK;
    unsigned voffA[2], voffB[2];
#pragma unroll
    for (int i = 0; i < 2; ++i) { int R, C; stage_rc(tid * 16 + i * 8192, R, C); const int Rb = Epi::PERM ? ((R & ~31) + perm32(R & 31)) : R;
        voffA[i] = (unsigned)(R * g.lda + C) * 2u; voffB[i] = (unsigned)(Rb * g.ldb + C) * 2u; }
    const size_t kstep = (size_t)(BK * 2);
    const size_t hstepA = (size_t)HALF * g.lda * 2, hstepB = (size_t)HALF * g.ldb * 2;
    const size_t tstepA = 2 * hstepA, tstepB = 2 * hstepB;
    const unsigned ldsw = (unsigned)wid * 1024u;
    const int aoff = lds_byte(wr * 64 + fr, fq * 8), boff = lds_byte(wc * 32 + fr, fq * 8);
#define PG8_SA(b, h) (((b) * 2 + (h)) * HTB)
#define PG8_SB(b, h) ((4 + (b) * 2 + (h)) * HTB)
#define PG8_STAGE(bufoff, gbase, voff) do { _Pragma("unroll") for (int _i = 0; _i < 2; ++_i) \
        __builtin_amdgcn_global_load_lds((const unsigned*)((const char*)(gbase) + (voff)[_i]), (PG8_LAS unsigned*)(lds + (bufoff) + ldsw + _i * 8192), 16, 0, 0); } while (0)
#define PG8_LDA(dst, b, h) do { _Pragma("unroll") for (int m = 0; m < 4; ++m) _Pragma("unroll") for (int k = 0; k < 2; ++k) dst[m][k] = *(const PG8_LAS bf16x8*)(lds + PG8_SA(b, h) + aoff + m * 2048 + k * 1024); } while (0)
#define PG8_LDB(dst, b, h) do { _Pragma("unroll") for (int n = 0; n < 2; ++n) _Pragma("unroll") for (int k = 0; k < 2; ++k) dst[n][k] = *(const PG8_LAS bf16x8*)(lds + PG8_SB(b, h) + boff + n * 2048 + k * 1024); } while (0)
#define PG8_MMA(ai, bj, At, Bt) do { __builtin_amdgcn_s_setprio(1); _Pragma("unroll") for (int m = 0; m < 4; ++m) _Pragma("unroll") for (int n = 0; n < 2; ++n) _Pragma("unroll") for (int k = 0; k < 2; ++k) \
        acc[ai][bj][m][n] = __builtin_amdgcn_mfma_f32_16x16x32_bf16(Bt[n][k], At[m][k], acc[ai][bj][m][n], 0, 0, 0); __builtin_amdgcn_s_setprio(0); } while (0)
#define PG8_WAIT_V(n) asm volatile("s_waitcnt vmcnt(" #n ")" ::: "memory")
#define PG8_WAIT_L(n) asm volatile("s_waitcnt lgkmcnt(" #n ")" ::: "memory")
#define PG8_BAR __builtin_amdgcn_s_barrier()
#define PG8_SCHED __builtin_amdgcn_sched_barrier(0)
#define PG8_UA(u) ((const char*)g.A + (size_t)(u).pm * tstepA + (size_t)((u).pn >> 1) * (size_t)g.a_koff * 2)
#define PG8_UB(u) ((const char*)g.Bt + (size_t)(u).pn * tstepB)
    Unit cur, nxt; int ui = 0;
    if (!S.next(0, cur)) return;
    f32x4 acc[2][2][4][2];
#pragma unroll
    for (int a = 0; a < 2; ++a)
#pragma unroll
        for (int b = 0; b < 2; ++b)
#pragma unroll
            for (int m = 0; m < 4; ++m)
#pragma unroll
                for (int n = 0; n < 2; ++n) acc[a][b][m][n] = (f32x4){0.f, 0.f, 0.f, 0.f};
    bf16x8 At[4][2], B0[2][2], B1[2][2];
    const char* cA = PG8_UA(cur); const char* cB = PG8_UB(cur);
    S.a_ready(cur);
    float rsv[2][4];
#define PG8_RS(u_) do { if constexpr (Epi::NEEDS_RS) { _Pragma("unroll") for (int ai_ = 0; ai_ < 2; ++ai_) _Pragma("unroll") for (int m_ = 0; m_ < 4; ++m_) rsv[ai_][m_] = row_scale(E.ssq, (u_).pm * BM + wr * 64 + fr + ai_ * HALF + m_ * 16); } } while (0)
    PG8_RS(cur);
    if constexpr (SP2) {
        PG8_STAGE(PG8_SB(0, 0), cB, voffB); PG8_STAGE(PG8_SB(0, 1), cB + hstepB, voffB); PG8_STAGE(PG8_SA(0, 0), cA, voffA); PG8_STAGE(PG8_SA(0, 1), cA + hstepA, voffA);
        if (wr == 1) PG8_BAR;
        PG8_WAIT_V(2); PG8_BAR;
        PG8_STAGE(PG8_SB(1, 0), cB + kstep, voffB); PG8_STAGE(PG8_SA(1, 0), cA + kstep, voffA); PG8_STAGE(PG8_SB(1, 1), cB + hstepB + kstep, voffB);
        PG8_WAIT_V(6); PG8_BAR;
    } else {
        PG8_STAGE(PG8_SB(0, 0), cB, voffB); PG8_STAGE(PG8_SA(0, 0), cA, voffA); PG8_STAGE(PG8_SB(0, 1), cB + hstepB, voffB); PG8_STAGE(PG8_SA(0, 1), cA + hstepA, voffA);
        if (wr == 1) PG8_BAR;
        PG8_WAIT_V(4); PG8_BAR;
        PG8_STAGE(PG8_SB(1, 0), cB + kstep, voffB); PG8_STAGE(PG8_SA(1, 0), cA + kstep, voffA); PG8_STAGE(PG8_SB(1, 1), cB + hstepB + kstep, voffB);
        PG8_WAIT_V(6); PG8_BAR;
    }
    for (;;) {
        const bool has_next = S.next(ui + 1, nxt);
        const char* nA = has_next ? PG8_UA(nxt) : cA; const char* nB = has_next ? PG8_UB(nxt) : cB;
        for (int t = 0; t < nt; t += 2) {
            const bool last = (t == nt - 2);
            const char* a1 = cA + (size_t)(t + 1) * kstep;
            const char* a2 = last ? nA : cA + (size_t)(t + 2) * kstep; const char* b2 = last ? nB : cB + (size_t)(t + 2) * kstep;
            const char* a3 = a2 + kstep; const char* b3 = b2 + kstep;
            if (last && has_next) S.a_ready(nxt);
            if constexpr (SP2) {
            PG8_LDB(B0, 0, 0); PG8_LDB(B1, 0, 1); PG8_SCHED; PG8_LDA(At, 0, 0); PG8_STAGE(PG8_SA(1, 1), a1 + hstepA, voffA);
            PG8_WAIT_V(8); PG8_WAIT_L(0); PG8_BAR; PG8_MMA(0, 0, At, B0); PG8_MMA(0, 1, At, B1); PG8_BAR; PG8_SCHED;
            PG8_LDA(At, 0, 1); PG8_STAGE(PG8_SB(0, 0), b2, voffB); PG8_STAGE(PG8_SB(0, 1), b2 + hstepB, voffB); PG8_STAGE(PG8_SA(0, 0), a2, voffA);
            PG8_WAIT_V(8); PG8_WAIT_L(0); PG8_BAR; PG8_MMA(1, 0, At, B0); PG8_MMA(1, 1, At, B1); PG8_BAR; PG8_SCHED;
            PG8_LDB(B0, 1, 0); PG8_LDB(B1, 1, 1); PG8_SCHED; PG8_LDA(At, 1, 0); PG8_STAGE(PG8_SA(0, 1), a2 + hstepA, voffA);
            PG8_WAIT_V(8); PG8_WAIT_L(0); PG8_BAR; PG8_MMA(0, 0, At, B0); PG8_MMA(0, 1, At, B1); PG8_BAR; PG8_SCHED;
            PG8_LDA(At, 1, 1); PG8_STAGE(PG8_SB(1, 0), b3, voffB); PG8_STAGE(PG8_SB(1, 1), b3 + hstepB, voffB); PG8_STAGE(PG8_SA(1, 0), a3, voffA);
            PG8_WAIT_V(8); PG8_WAIT_L(0); PG8_BAR; PG8_MMA(1, 0, At, B0); PG8_MMA(1, 1, At, B1); PG8_BAR; PG8_SCHED;
            } else {
            PG8_LDB(B0, 0, 0); PG8_SCHED; PG8_LDA(At, 0, 0); PG8_STAGE(PG8_SA(1, 1), a1 + hstepA, voffA);
            PG8_WAIT_L(8); PG8_BAR; PG8_WAIT_L(0); PG8_MMA(0, 0, At, B0); PG8_BAR; PG8_SCHED;
            PG8_LDB(B1, 0, 1); PG8_STAGE(PG8_SB(0, 0), b2, voffB);
            PG8_BAR; PG8_WAIT_L(0); PG8_MMA(0, 1, At, B1); PG8_BAR;
            PG8_LDA(At, 0, 1); PG8_STAGE(PG8_SA(0, 0), a2, voffA);
            PG8_BAR; PG8_WAIT_L(0); PG8_MMA(1, 0, At, B0); PG8_BAR; PG8_SCHED;
            PG8_STAGE(PG8_SB(0, 1), b2 + hstepB, voffB);
            PG8_WAIT_V(6); PG8_BAR; PG8_MMA(1, 1, At, B1); PG8_BAR;
            PG8_LDB(B0, 1, 0); PG8_SCHED; PG8_LDA(At, 1, 0); PG8_STAGE(PG8_SA(0, 1), a2 + hstepA, voffA);
            PG8_WAIT_L(8); PG8_BAR; PG8_WAIT_L(0); PG8_MMA(0, 0, At, B0); PG8_BAR; PG8_SCHED;
            PG8_LDB(B1, 1, 1); PG8_STAGE(PG8_SB(1, 0), b3, voffB);
            PG8_BAR; PG8_WAIT_L(0); PG8_MMA(0, 1, At, B1); PG8_BAR;
            PG8_LDA(At, 1, 1); PG8_STAGE(PG8_SA(1, 0), a3, voffA);
            PG8_BAR; PG8_WAIT_L(0); PG8_MMA(1, 0, At, B0); PG8_BAR; PG8_SCHED;
            PG8_STAGE(PG8_SB(1, 1), b3 + hstepB, voffB);
            PG8_WAIT_V(6); PG8_BAR; PG8_MMA(1, 1, At, B1); PG8_BAR;
            }
        }
        if constexpr (ALIGN_EPI) { if (wr == 0) PG8_BAR; }
        E(acc, cur, wr, wc, fr, fq, rsv); S.done(cur);
        if (has_next) PG8_RS(nxt);
        if (!has_next) break;
#pragma unroll
        for (int a = 0; a < 2; ++a)
#pragma unroll
            for (int b = 0; b < 2; ++b)
#pragma unroll
                for (int m = 0; m < 4; ++m)
#pragma unroll
                    for (int n = 0; n < 2; ++n) acc[a][b][m][n] = (f32x4){0.f, 0.f, 0.f, 0.f};
        cur = nxt; cA = nA; cB = nB; ++ui;
        if constexpr (ALIGN_EPI) { if (wr == 1) PG8_BAR; }
    }
    PG8_WAIT_V(0);
    if constexpr (!ALIGN_EPI) { if (wr == 0) PG8_BAR; }
    PG8_BAR;
#undef PG8_SA
#undef PG8_SB
#undef PG8_STAGE
#undef PG8_LDA
#undef PG8_LDB
#undef PG8_MMA
#undef PG8_WAIT_V
#undef PG8_WAIT_L
#undef PG8_BAR
#undef PG8_SCHED
#undef PG8_UA
#undef PG8_UB
#undef PG8_RS
}

__device__ __forceinline__ float row_scale(const float* ssq, int row) { const f32x4 a = *(const f32x4*)(ssq + (size_t)row * 8), b = *(const f32x4*)(ssq + (size_t)row * 8 + 4);
    return __builtin_amdgcn_rsqf((((a[0] + a[1]) + (a[2] + a[3])) + ((b[0] + b[1]) + (b[2] + b[3]))) * (1.0f / 2048.0f) + 1e-6f); }
__device__ __forceinline__ void unpack8(u32x4 w, f32x4& a, f32x4& b) { a[0] = __uint_as_float(w.x << 16); a[1] = __uint_as_float(w.x & 0xffff0000u); a[2] = __uint_as_float(w.y << 16); a[3] = __uint_as_float(w.y & 0xffff0000u);
    b[0] = __uint_as_float(w.z << 16); b[1] = __uint_as_float(w.z & 0xffff0000u); b[2] = __uint_as_float(w.w << 16); b[3] = __uint_as_float(w.w & 0xffff0000u); }
__device__ __forceinline__ u32x4 pack8(f32x4 a, f32x4 b) { u32x4 w; w.x = cvt_pk_bf16(a[0], a[1]); w.y = cvt_pk_bf16(a[2], a[3]); w.z = cvt_pk_bf16(b[0], b[1]); w.w = cvt_pk_bf16(b[2], b[3]); return w; }

struct EpiResid {
    static constexpr bool PERM = true, NEEDS_RS = false;
    float* X; bf16_t* XB; float* ssq; const float* cs; PG8_LAS float* red;
    __device__ __forceinline__ void operator()(const f32x4 (&acc)[2][2][4][2], const Unit& u, int wr, int wc, int fr, int fq, const float (&rsv)[2][4]) const {
        const int row0 = u.pm * BM + wr * 64 + fr, col0 = u.pn * BM + wc * 32 + 8 * fq;
        f32x4 cv[2][2];
#pragma unroll
        for (int bj = 0; bj < 2; ++bj)
#pragma unroll
            for (int n = 0; n < 2; ++n) cv[bj][n] = cs ? *(const f32x4*)(cs + col0 + bj * HALF + 4 * n) : (f32x4){1.f, 1.f, 1.f, 1.f};
#pragma unroll
        for (int ai = 0; ai < 2; ++ai)
#pragma unroll
            for (int m = 0; m < 4; ++m) { const int row = row0 + ai * HALF + m * 16; float ss = 0.f;
#pragma unroll
                for (int bj = 0; bj < 2; ++bj) { bf16_t* xp = XB + (size_t)row * D + col0 + bj * HALF;
                    f32x4 a, b; unpack8(*(const u32x4*)xp, a, b);
                    a += acc[ai][bj][m][0] * cv[bj][0]; b += acc[ai][bj][m][1] * cv[bj][1];
                    const u32x4 w = pack8(a, b); *(u32x4*)xp = w; unpack8(w, a, b);
                    ss += (a[0] * a[0] + a[1] * a[1]) + (a[2] * a[2] + a[3] * a[3]) + (b[0] * b[0] + b[1] * b[1]) + (b[2] * b[2] + b[3] * b[3]); }
                ss += __shfl_xor(ss, 16); ss += __shfl_xor(ss, 32);
                if (fq == 0) red[(ai * HALF + wr * 64 + m * 16 + fr) * 4 + wc] = ss;
                asm volatile("" ::: "memory"); }
        asm volatile("s_waitcnt lgkmcnt(0)" ::: "memory"); __builtin_amdgcn_s_barrier(); asm volatile("" ::: "memory");
        const int t = wc * 64 + fq * 16 + fr;
        if (wr == 0) { const f32x4 v = *(const PG8_LAS f32x4*)(red + t * 4); ssq[(size_t)(u.pm * BM + t) * 8 + u.pn] = (v[0] + v[1]) + (v[2] + v[3]); }
    }
};
struct EpiFfn1 {
    static constexpr bool PERM = true, NEEDS_RS = true;
    bf16_t* H; const float* ssq;
    __device__ __forceinline__ void operator()(const f32x4 (&acc)[2][2][4][2], const Unit& u, int wr, int wc, int fr, int fq, const float (&rsv)[2][4]) const {
        const int row0 = u.pm * BM + wr * 64 + fr, col0 = u.pn * HALF + wc * 32 + 8 * fq;
#pragma unroll
        for (int ai = 0; ai < 2; ++ai)
#pragma unroll
            for (int m = 0; m < 4; ++m) { const int row = row0 + ai * HALF + m * 16; const float rs = rsv[ai][m];
                float g[8], sg[8]; f32x4 o[2];
#pragma unroll
                for (int j = 0; j < 8; ++j) g[j] = acc[ai][0][m][j >> 2][j & 3] * rs;
                sigmoid8(g, sg);
#pragma unroll
                for (int j = 0; j < 8; ++j) o[j >> 2][j & 3] = (g[j] * sg[j]) * (acc[ai][1][m][j >> 2][j & 3] * rs);
                *(u32x4*)(H + (size_t)row * FF + col0) = pack8(o[0], o[1]); }
    }
};
struct EpiHgrn {
    static constexpr bool PERM = true, NEEDS_RS = true;
    bf16_t* Q; float* LOGF; bf16_t* V; bf16_t* GS; const float* ssq; const float* lb;
    __device__ __forceinline__ void operator()(const f32x4 (&acc)[2][2][4][2], const Unit& u, int wr, int wc, int fr, int fq, const float (&rsv)[2][4]) const {
        const int seg = u.pn >> 3, row0 = u.pm * BM + wr * 64 + fr, col0 = (u.pn & 7) * BM + wc * 32 + 8 * fq;
        f32x4 lbv[2][2];
        if (seg == 1) {
#pragma unroll
            for (int bj = 0; bj < 2; ++bj)
#pragma unroll
                for (int n = 0; n < 2; ++n) lbv[bj][n] = *(const f32x4*)(lb + col0 + bj * HALF + 4 * n);
        }
#pragma unroll
        for (int ai = 0; ai < 2; ++ai)
#pragma unroll
            for (int m = 0; m < 4; ++m) { const int row = row0 + ai * HALF + m * 16; const float rs = rsv[ai][m];
#pragma unroll
                for (int bj = 0; bj < 2; ++bj) { f32x4 a = acc[ai][bj][m][0] * rs, b = acc[ai][bj][m][1] * rs; const size_t off = (size_t)row * D + col0 + bj * HALF;
                    if (seg == 1) { float z[8], sg[8];
#pragma unroll
                        for (int j = 0; j < 4; ++j) { z[j] = a[j]; z[4 + j] = b[j]; }
                        sigmoid8(z, sg);
#pragma unroll
                        for (int j = 0; j < 8; ++j) { const float l = lbv[bj][j >> 2][j & 3]; z[j] = fmaxf(l + (1.f - l) * sg[j], 1e-6f); }
#pragma unroll
                        for (int j = 0; j < 8; ++j) z[j] = __builtin_amdgcn_logf(z[j]);
#pragma unroll
                        for (int j = 0; j < 4; ++j) { a[j] = z[j]; b[j] = z[4 + j]; }
                        u32x4 lw_; lw_.x = pk_f16(a[0], a[1]); lw_.y = pk_f16(a[2], a[3]); lw_.z = pk_f16(b[0], b[1]); lw_.w = pk_f16(b[2], b[3]);
                        *(u32x4*)((unsigned short*)LOGF + off) = lw_;
                    } else {
                        if (seg == 3) { float z[8], sg[8];
#pragma unroll
                            for (int j = 0; j < 4; ++j) { z[j] = a[j]; z[4 + j] = b[j]; }
                            sigmoid8(z, sg);
#pragma unroll
                            for (int j = 0; j < 4; ++j) { a[j] = z[j] * sg[j]; b[j] = z[4 + j] * sg[4 + j]; } }
                        bf16_t* dst = (bf16_t*)((char*)Q + (size_t)(seg ? seg + 1 : 0) * (65 * MiB));
                        *(u32x4*)(dst + off) = pack8(a, b); } } }
    }
};
struct EpiQkv {
    static constexpr bool PERM = true, NEEDS_RS = true;
    bf16_t* Q; bf16_t* Kb; bf16_t* Vb; float* out; const float* ssq;
    __device__ __forceinline__ void operator()(const f32x4 (&acc)[2][2][4][2], const Unit& u, int wr, int wc, int fr, int fq, const float (&rsv)[2][4]) const {
        const int seg = u.pn >> 3, row0 = u.pm * BM + wr * 64 + fr, col0 = (u.pn & 7) * BM + wc * 32 + 8 * fq;
        bf16_t* dst = (bf16_t*)((char*)Q + (size_t)(seg + (seg >> 1)) * (65 * MiB));
        const bool smp = u.pm >= 64; const int frow0 = smp ? row0 - MP : row0;
        float* fo = out + (smp ? OFF_K_S : OFF_K_P) + (size_t)(seg ? seg - 1 : 0) * (smp ? (OFF_V_S - OFF_K_S) : (OFF_V_P - OFF_K_P));
#pragma unroll
        for (int ai = 0; ai < 2; ++ai)
#pragma unroll
            for (int m = 0; m < 4; ++m) { const int row = row0 + ai * HALF + m * 16; const float rs = rsv[ai][m];
#pragma unroll
                for (int bj = 0; bj < 2; ++bj) { const f32x4 a = acc[ai][bj][m][0] * rs, b = acc[ai][bj][m][1] * rs; const size_t off = (size_t)row * D + col0 + bj * HALF;
                    *(u32x4*)(dst + off) = pack8(a, b);
                    if (seg) { float* p = fo + (size_t)(frow0 + ai * HALF + m * 16) * D + col0 + bj * HALF; *(f32x4*)p = a; *(f32x4*)(p + 4) = b; } } }
    }
};
}

namespace sk {
__device__ __forceinline__ int crow(int r, int hi) { return (r & 3) + 8 * (r >> 2) + 4 * hi; }
__device__ __forceinline__ float row_scale_s(const float* ssqS, int row) { float t = 0.f;
#pragma unroll
    for (int i = 0; i < 16; ++i) { const f32x4 a = *(const f32x4*)(ssqS + (size_t)row * 64 + 4 * i); t += (a[0] + a[1]) + (a[2] + a[3]); }
    return __builtin_amdgcn_rsqf(t * (1.0f / 2048.0f) + 1e-6f); }
template <class Epi, int NC>
__device__ __forceinline__ void skinny_phase(const bf16* __restrict__ A, int lda, int a_goff, const bf16* __restrict__ Bt, int ldb, int K, int ncg, int vcu, int G, const Epi& E, LAS float* rs_tab, LAS unsigned char* lds) {
    const int tid = opaque_tid(), w = __builtin_amdgcn_readfirstlane(tid >> 6), lane = tid & 63, r32 = lane & 31, hi = lane >> 5, rblk = w & 1, kq = w >> 1;
    if (Epi::NEEDS_RS) { if (tid < 256) rs_tab[tid] = row_scale_s(E.ssqS, tid); }
    asm volatile("s_waitcnt lgkmcnt(0)" ::: "memory"); __builtin_amdgcn_s_barrier(); asm volatile("" ::: "memory");
    constexpr int BUF = 32768 + NC * 16384, NW2 = 2 * NC;
    const int srow = tid >> 5, sslot = tid & 31, nsc = K / 256;
    const int st0 = srow * 512 + ((sslot ^ (srow & 15)) << 4);
    const int rrow = 32 * rblk + r32;
    const int NU = 4 * (ncg / NC);
    bf16x8 ra[3][4], rw[3][NW2];
    const bf16* pa = A; const bf16* pw[NW2];
#pragma unroll
    for (int i = 0; i < NW2; ++i) pw[i] = Bt;
#define SK_PTRS(u_) do { const int cg_ = ((u_) >> 2) * NC, rb_ = (u_) & 3; \
        pa = A + (size_t)(64 * rb_ + srow) * lda + (size_t)(cg_ >> 4) * a_goff + sslot * 8; \
        _Pragma("unroll") for (int i = 0; i < NW2; ++i) pw[i] = Bt + (size_t)E.wrow(cg_ + (i >> 1), srow + 16 * (i & 1)) * ldb + sslot * 8; \
        asm volatile("" : "+v"(pa)); \
        _Pragma("unroll") for (int i = 0; i < NW2; ++i) asm volatile("" : "+v"(pw[i])); } while (0)
#define SK_LOAD(s_, c) do { _Pragma("unroll") for (int i = 0; i < 4; ++i) ra[s_][i] = *(const bf16x8*)(pa + (size_t)(16 * i) * lda + (c) * 256); \
        _Pragma("unroll") for (int i = 0; i < NW2; ++i) rw[s_][i] = *(const bf16x8*)(pw[i] + (c) * 256); } while (0)
#define SK_LOAD3() do { SK_LOAD(0, 0); if (1 < nsc) SK_LOAD(1, 1); if (2 < nsc) SK_LOAD(2, 2); } while (0)
#define SK_WRITE(s_, b) do { LAS unsigned char* bb = lds + (b) * BUF; _Pragma("unroll") for (int i = 0; i < 4; ++i) *(LAS bf16x8*)(bb + st0 + i * 8192) = ra[s_][i]; \
        _Pragma("unroll") for (int i = 0; i < NW2; ++i) *(LAS bf16x8*)(bb + 32768 + st0 + i * 8192) = rw[s_][i]; } while (0)
#define SK_STEP(j) do { const int c = c3 + (j); if (c < nsc) { \
            if (c + 1 < nsc) SK_WRITE(((j) + 1) % 3, (c + 1) & 1); \
            if (c + 3 < nsc) SK_LOAD((j), c + 3); \
            const LAS unsigned char* bb = lds + (c & 1) * BUF; \
            _Pragma("unroll") for (int i = 0; i < 4; ++i) { const int sl = 8 * kq + 2 * i + hi; \
                const bf16x8 af = *(const LAS bf16x8*)(bb + rrow * 512 + ((sl ^ (rrow & 15)) << 4)); \
                _Pragma("unroll") for (int g = 0; g < NC; ++g) { const bf16x8 wf = *(const LAS bf16x8*)(bb + 32768 + (32 * g + r32) * 512 + ((sl ^ (r32 & 15)) << 4)); \
                    acc[g] = __builtin_amdgcn_mfma_f32_32x32x16_bf16(wf, af, acc[g], 0, 0, 0); } } \
            asm volatile("s_waitcnt lgkmcnt(0)" ::: "memory"); __builtin_amdgcn_s_barrier(); asm volatile("" ::: "memory"); } } while (0)
    int u = vcu;
    if (u < NU) { SK_PTRS(u); SK_LOAD3(); }
#pragma unroll 1
    while (u < NU) {
        const int cg = (u >> 2) * NC, rb = u & 3;
        f32x16 acc[NC] = {};
        SK_WRITE(0, 0);
        asm volatile("s_waitcnt lgkmcnt(0)" ::: "memory"); __builtin_amdgcn_s_barrier(); asm volatile("" ::: "memory");
#pragma unroll 1
        for (int c3 = 0; c3 < nsc; c3 += 3) { SK_STEP(0); SK_STEP(1); SK_STEP(2); }
        const int un = u + G;
        if (un < NU) { SK_PTRS(un); SK_LOAD3(); }
        LAS float* pb = (LAS float*)lds + (w * NC) * 1024 + lane;
        asm volatile("" : "+v"(pb));
#pragma unroll
        for (int g = 0; g < NC; ++g)
#pragma unroll
            for (int r = 0; r < 16; ++r) pb[(g * 16 + r) * 64] = acc[g][r];
        asm volatile("s_waitcnt lgkmcnt(0)" ::: "memory"); __builtin_amdgcn_s_barrier(); asm volatile("" ::: "memory");
        if (kq == 0) {
            const int row = 64 * rb + rrow; const float rs = Epi::NEEDS_RS ? rs_tab[row] : 1.f;
#pragma unroll
            for (int g = 0; g < NC; ++g) {
#pragma unroll
                for (int r = 0; r < 16; ++r) { const int o_ = (g * 16 + r) * 64; acc[g][r] = ((pb[o_] + pb[o_ + 2 * NC * 1024]) + pb[o_ + 4 * NC * 1024]) + pb[o_ + 6 * NC * 1024]; }
                E(acc[g], cg + g, row, hi, rs); }
        }
        asm volatile("s_waitcnt lgkmcnt(0)" ::: "memory"); __builtin_amdgcn_s_barrier(); asm volatile("" ::: "memory");
        u = un;
    }
#undef SK_PTRS
#undef SK_LOAD
#undef SK_LOAD3
#undef SK_WRITE
#undef SK_STEP
}
__device__ __forceinline__ u32x2 pack4(float a, float b, float c, float d) { u32x2 w; w.x = cvt_pk_bf16(a, b); w.y = cvt_pk_bf16(c, d); return w; }
struct SkResid {
    static constexpr bool NEEDS_RS = false;
    float* X; bf16* XB; float* ssqS; const float* cs;
    __device__ __forceinline__ int wrow(int u, int m) const { return 32 * u + m; }
    __device__ __forceinline__ void operator()(const f32x16& acc, int u, int row, int hi, float) const {
        float ss = 0.f;
#pragma unroll
        for (int q = 0; q < 4; ++q) { const int c = 32 * u + 8 * q + 4 * hi; bf16* xp = XB + (size_t)(MP + row) * D + c;
            const u32x2 w0 = *(const u32x2*)xp; f32x4 xv = {__uint_as_float(w0.x << 16), __uint_as_float(w0.x & 0xffff0000u), __uint_as_float(w0.y << 16), __uint_as_float(w0.y & 0xffff0000u)};
            f32x4 av = {acc[4 * q], acc[4 * q + 1], acc[4 * q + 2], acc[4 * q + 3]};
            if (cs) av *= *(const f32x4*)(cs + c);
            xv += av; const u32x2 w1 = pack4(xv[0], xv[1], xv[2], xv[3]); *(u32x2*)xp = w1;
            xv = (f32x4){__uint_as_float(w1.x << 16), __uint_as_float(w1.x & 0xffff0000u), __uint_as_float(w1.y << 16), __uint_as_float(w1.y & 0xffff0000u)};
            ss += (xv[0] * xv[0] + xv[1] * xv[1]) + (xv[2] * xv[2] + xv[3] * xv[3]); }
        ss += __shfl_xor(ss, 32);
        if (hi == 0) ssqS[(size_t)row * 64 + u] = ss;
    }
};
struct SkFfn1 {
    static constexpr bool NEEDS_RS = true;
    bf16* H; const float* ssqS;
    __device__ __forceinline__ int wrow(int u, int m) const { const int j = 16 * u + (m & 15); return (j >> 7) * 256 + (j & 127) + (m >> 4) * 128; }
    __device__ __forceinline__ void operator()(const f32x16& acc, int u, int row, int hi, float rs) const {
#pragma unroll
        for (int q = 0; q < 2; ++q) { float o[4];
#pragma unroll
            for (int i = 0; i < 4; ++i) { const float gt = acc[4 * q + i] * rs, up = acc[4 * q + i + 8] * rs; o[i] = gt * sigmoidf_(gt) * up; }
            *(u32x2*)(H + (size_t)(MP + row) * FF + 16 * u + 8 * q + 4 * hi) = pack4(o[0], o[1], o[2], o[3]); }
    }
};
struct SkHgrn {
    static constexpr bool NEEDS_RS = true;
    bf16* Q; float* LOGF; const float* ssqS; const float* lb;
    __device__ __forceinline__ int wrow(int u, int m) const { return 32 * u + m; }
    __device__ __forceinline__ void operator()(const f32x16& acc, int u, int row, int hi, float rs) const {
        const int seg = u >> 6;
#pragma unroll
        for (int q = 0; q < 4; ++q) { const int c = 32 * (u & 63) + 8 * q + 4 * hi; const size_t off = (size_t)(MP + row) * D + c;
            f32x4 a = {acc[4 * q] * rs, acc[4 * q + 1] * rs, acc[4 * q + 2] * rs, acc[4 * q + 3] * rs};
            if (seg == 1) { const f32x4 l = *(const f32x4*)(lb + c);
#pragma unroll
                for (int j = 0; j < 4; ++j) a[j] = __builtin_amdgcn_logf(fmaxf(l[j] + (1.f - l[j]) * sigmoidf_(a[j]), 1e-6f));
                u32x2 lw_; lw_.x = pk_f16(a[0], a[1]); lw_.y = pk_f16(a[2], a[3]); *(u32x2*)((unsigned short*)LOGF + off) = lw_;
            } else {
                if (seg == 3) {
#pragma unroll
                    for (int j = 0; j < 4; ++j) a[j] = a[j] * sigmoidf_(a[j]); }
                bf16* dst = (bf16*)((char*)Q + (size_t)(seg ? seg + 1 : 0) * (65 * MiB));
                *(u32x2*)(dst + off) = pack4(a[0], a[1], a[2], a[3]); } }
    }
};
struct SkQkv {
    static constexpr bool NEEDS_RS = true;
    bf16* Q; float* out; const float* ssqS;
    __device__ __forceinline__ int wrow(int u, int m) const { return 32 * u + m; }
    __device__ __forceinline__ void operator()(const f32x16& acc, int u, int row, int hi, float rs) const {
        const int seg = u >> 6;
        bf16* dst = (bf16*)((char*)Q + (size_t)(seg + (seg >> 1)) * (65 * MiB));
        float* fo = out + OFF_K_S + (size_t)(seg ? seg - 1 : 0) * (OFF_V_S - OFF_K_S);
#pragma unroll
        for (int q = 0; q < 4; ++q) { const int c = 32 * (u & 63) + 8 * q + 4 * hi;
            const f32x4 a = {acc[4 * q] * rs, acc[4 * q + 1] * rs, acc[4 * q + 2] * rs, acc[4 * q + 3] * rs};
            *(u32x2*)(dst + (size_t)(MP + row) * D + c) = pack4(a[0], a[1], a[2], a[3]);
            if (seg) *(f32x4*)(fo + (size_t)row * D + c) = a; }
    }
};
}

namespace att {
constexpr int KVBLK = 64, QBLK = 32, NW = 8, LD = 2048;
constexpr float SCALE = ATT_SCALE, THR = 8.f;
constexpr int SHM_V = KVBLK * 128 * 2, SHM_K = KVBLK * 128 * 2;
#define KSWZ(row, colB) ((row) * 256 + ((colB) ^ (((row) & 7) << 4)))
#define SBAR() __builtin_amdgcn_sched_barrier(0)
__device__ __forceinline__ int crow(int r, int hi) { return (r & 3) + 8 * (r >> 2) + 4 * hi; }
__device__ __forceinline__ void partialSM(f32x16& p0, f32x16& p1, float& m_reg, float& mn, float& alpha) {
  constexpr float C = SCALE * 1.4426950408889634f;
  float pmax = fmaxf(p0[0], p1[0]);
#pragma unroll
  for (int r = 1; r < 16; ++r) pmax = __builtin_fmaxf(__builtin_fmaxf(pmax, p0[r]), p1[r]);
  { auto rr = __builtin_amdgcn_permlane32_swap(__float_as_uint(pmax), __float_as_uint(pmax), false, false);
    pmax = fmaxf(__uint_as_float(rr[0]), __uint_as_float(rr[1])); }
  if (__builtin_expect(__all(pmax - m_reg <= THR / SCALE), 1)) { mn = m_reg; alpha = 1.f; }
  else { mn = fmaxf(m_reg, pmax); alpha = __builtin_amdgcn_exp2f((m_reg - mn) * C); m_reg = mn; }
  float mnC = -mn * C;
#pragma unroll
  for (int r = 0; r < 16; ++r) p0[r] = fmaf(p0[r], C, mnC);
#pragma unroll
  for (int r = 0; r < 16; ++r) p1[r] = fmaf(p1[r], C, mnC);
#pragma unroll
  for (int r = 0; r < 16; ++r) p0[r] = __builtin_amdgcn_exp2f(p0[r]);
}
__device__ __forceinline__ void finishSM(f32x16& p0, f32x16& p1, float alpha, float& l_reg, bf16x8& pa0, bf16x8& pa1, bf16x8& pa2, bf16x8& pa3) {
#pragma unroll
  for (int r = 0; r < 16; ++r) p1[r] = __builtin_amdgcn_exp2f(p1[r]);
  float ps = 0;
#pragma unroll
  for (int r = 0; r < 16; ++r) ps += p0[r];
#pragma unroll
  for (int r = 0; r < 16; ++r) ps += p1[r];
  { auto rr = __builtin_amdgcn_permlane32_swap(__float_as_uint(ps), __float_as_uint(ps), false, false);
    ps = __uint_as_float(rr[0]) + __uint_as_float(rr[1]); }
  l_reg = l_reg * alpha + ps;
#define PK4(P, BASE, OUT) do { unsigned a0 = cvt_pk_bf16(P[BASE + 0], P[BASE + 1]), a1 = cvt_pk_bf16(P[BASE + 2], P[BASE + 3]);   \
    unsigned b0 = cvt_pk_bf16(P[BASE + 4], P[BASE + 5]), b1 = cvt_pk_bf16(P[BASE + 6], P[BASE + 7]);                              \
    auto r0 = __builtin_amdgcn_permlane32_swap(a0, b0, false, false); auto r1 = __builtin_amdgcn_permlane32_swap(a1, b1, false, false); \
    u32x4 w = {r0[0], r1[0], r0[1], r1[1]}; OUT = *reinterpret_cast<bf16x8*>(&w); } while (0)
  PK4(p0, 0, pa0); PK4(p0, 8, pa1); PK4(p1, 0, pa2); PK4(p1, 8, pa3);
#undef PK4
}
__device__ __forceinline__ void qkt(f32x16& p0, f32x16& p1, const char* Ks, const bf16x8* qr, int r32, int hi) {
  p0 = f32x16{}; p1 = f32x16{};
#pragma unroll
  for (int d0 = 0; d0 < 8; ++d0) { int cb = (d0 * 16 + hi * 8) * 2;
    bf16x8 b0 = *reinterpret_cast<const bf16x8*>(Ks + KSWZ(r32, cb));
    bf16x8 b1 = *reinterpret_cast<const bf16x8*>(Ks + KSWZ(32 + r32, cb));
    p0 = __builtin_amdgcn_mfma_f32_32x32x16_bf16(b0, qr[d0], p0, 0, 0, 0);
    p1 = __builtin_amdgcn_mfma_f32_32x32x16_bf16(b1, qr[d0], p1, 0, 0, 0); }
}
__device__ __forceinline__ int v_st(int k, int c) { const int kk = (k & ~0xC) | ((k & 4) << 1) | ((k & 8) >> 1); return ((kk >> 3) * 4 + (c >> 5)) * 512 + ((kk & 7) * 32 + (c & 31)) * 2; }
__device__ __forceinline__ int v_rd_base(int lane) { return ((lane & 3) << 3) | (((lane >> 2) & 3) << 6) | (((lane >> 4) & 1) << 5) | (((lane >> 5) & 1) << 8); }
constexpr int v_rd_off(int d0, int ks, int half) { return d0 * 512 + ks * 4096 + half * 2048; }
template <int OFF> __device__ __forceinline__ s16x4 tr_read(int vb) {
  s16x4 r; asm volatile("ds_read_b64_tr_b16 %0, %1 offset:%2" : "=&v"(r) : "v"(vb), "i"(OFF) : "memory"); return r;
}
template <int D0> __device__ __forceinline__ void pv_one(f32x16& od, int vb, bf16x8 pa0, bf16x8 pa1, bf16x8 pa2, bf16x8 pa3) {
  const s16x4 l0 = tr_read<v_rd_off(D0, 0, 0)>(vb), h0 = tr_read<v_rd_off(D0, 0, 1)>(vb), l1 = tr_read<v_rd_off(D0, 1, 0)>(vb), h1 = tr_read<v_rd_off(D0, 1, 1)>(vb);
  const s16x4 l2 = tr_read<v_rd_off(D0, 2, 0)>(vb), h2 = tr_read<v_rd_off(D0, 2, 1)>(vb), l3 = tr_read<v_rd_off(D0, 3, 0)>(vb), h3 = tr_read<v_rd_off(D0, 3, 1)>(vb);
  asm volatile("s_waitcnt lgkmcnt(0)" ::: "memory"); SBAR();
#define PK(L, H) (bf16x8){L[0], L[1], L[2], L[3], H[0], H[1], H[2], H[3]}
  od = __builtin_amdgcn_mfma_f32_32x32x16_bf16(pa0, PK(l0, h0), od, 0, 0, 0);
  od = __builtin_amdgcn_mfma_f32_32x32x16_bf16(pa1, PK(l1, h1), od, 0, 0, 0);
  od = __builtin_amdgcn_mfma_f32_32x32x16_bf16(pa2, PK(l2, h2), od, 0, 0, 0);
  od = __builtin_amdgcn_mfma_f32_32x32x16_bf16(pa3, PK(l3, h3), od, 0, 0, 0);
#undef PK
}
template <int D0> __device__ __forceinline__ void pv_two(f32x16& oa, f32x16& ob, int vb, bf16x8 pa0, bf16x8 pa1, bf16x8 pa2, bf16x8 pa3, bf16x8 pb0, bf16x8 pb1, bf16x8 pb2, bf16x8 pb3) {
  const s16x4 l0 = tr_read<v_rd_off(D0, 0, 0)>(vb), h0 = tr_read<v_rd_off(D0, 0, 1)>(vb), l1 = tr_read<v_rd_off(D0, 1, 0)>(vb), h1 = tr_read<v_rd_off(D0, 1, 1)>(vb);
  const s16x4 l2 = tr_read<v_rd_off(D0, 2, 0)>(vb), h2 = tr_read<v_rd_off(D0, 2, 1)>(vb), l3 = tr_read<v_rd_off(D0, 3, 0)>(vb), h3 = tr_read<v_rd_off(D0, 3, 1)>(vb);
  asm volatile("s_waitcnt lgkmcnt(0)" ::: "memory"); SBAR();
#define PK2(L, H) (bf16x8){L[0], L[1], L[2], L[3], H[0], H[1], H[2], H[3]}
  oa = __builtin_amdgcn_mfma_f32_32x32x16_bf16(pa0, PK2(l0, h0), oa, 0, 0, 0); ob = __builtin_amdgcn_mfma_f32_32x32x16_bf16(pb0, PK2(l0, h0), ob, 0, 0, 0);
  oa = __builtin_amdgcn_mfma_f32_32x32x16_bf16(pa1, PK2(l1, h1), oa, 0, 0, 0); ob = __builtin_amdgcn_mfma_f32_32x32x16_bf16(pb1, PK2(l1, h1), ob, 0, 0, 0);
  oa = __builtin_amdgcn_mfma_f32_32x32x16_bf16(pa2, PK2(l2, h2), oa, 0, 0, 0); ob = __builtin_amdgcn_mfma_f32_32x32x16_bf16(pb2, PK2(l2, h2), ob, 0, 0, 0);
  oa = __builtin_amdgcn_mfma_f32_32x32x16_bf16(pa3, PK2(l3, h3), oa, 0, 0, 0); ob = __builtin_amdgcn_mfma_f32_32x32x16_bf16(pb3, PK2(l3, h3), ob, 0, 0, 0);
#undef PK2
}
__device__ __forceinline__ void pv_d0(f32x16* o, int vb, bf16x8 pa0, bf16x8 pa1, bf16x8 pa2, bf16x8 pa3) {
  pv_one<0>(o[0], vb, pa0, pa1, pa2, pa3); pv_one<1>(o[1], vb, pa0, pa1, pa2, pa3); pv_one<2>(o[2], vb, pa0, pa1, pa2, pa3); pv_one<3>(o[3], vb, pa0, pa1, pa2, pa3);
}
__device__ __forceinline__ void fix_prompt(f32x16& p0, f32x16& p1, int jt, int lim, int qrow0, int r32, int hi, const float* lut) {
  if (jt > lim) {
#pragma unroll
    for (int r = 0; r < 16; ++r) { p0[r] = -1e30f; p1[r] = -1e30f; }
  } else if (64 * jt >= qrow0 - 153) {
    const float* lp = lut + (64 * jt - (qrow0 + r32) + 192);
#pragma unroll
    for (int r = 0; r < 16; ++r) { p0[r] += lp[crow(r, hi)]; p1[r] += lp[32 + crow(r, hi)]; }
  }
}

#define RESC(a) do { if (__any((a) < 1.f)) { if (hi == 0) al_l[r32] = (a); asm volatile("s_waitcnt lgkmcnt(0)" ::: "memory"); \
    _Pragma("unroll") for (int d = 0; d < 4; ++d) _Pragma("unroll") for (int r = 0; r < 16; ++r) o[d][r] *= al_l[crow(r, hi)]; } } while (0)
__device__ __forceinline__ void attn_unit2(const bf16* __restrict__ Qb, const bf16* __restrict__ Kh, const bf16* __restrict__ Vh, bf16* __restrict__ Ob,
                                           int NT, int lim, int qrow0, const float* lut, char* lds, float* scr) {
  const int tid = opaque_tid(), wid = __builtin_amdgcn_readfirstlane(tid >> 6), lane = tid & 63, r32 = lane & 31, hi = lane >> 5, a = wid & 3;
  const bool isA = wid < 4;
  char* K_lds = lds; char* V_lds = lds + 32768; char* P_lds = lds + 98304 + a * 4096;
  float* alpha_l = scr + a * 32; float* l_l = scr + 256 + a * 32;
  unsigned kgo[4], vgo[4];
#pragma unroll
  for (int i = 0; i < 4; ++i) { const int pq = 4 * a + i, g = 64 * pq + lane;
    { const int row = g >> 4, cc = (g & 15) ^ (row & 7); kgo[i] = (unsigned)(row * LD + cc * 8) * 2u; }
    { const int sub = g >> 5, kk = (sub >> 2) * 8 + ((g >> 2) & 7), k = (kk & ~0xC) | ((kk & 4) << 1) | ((kk & 8) >> 1), col = (sub & 3) * 32 + (g & 3) * 8; vgo[i] = (unsigned)(k * LD + col) * 2u; } }
  const int vrb = (int)(uintptr_t)V_lds + v_rd_base(lane);
  LAS char* K_las = (LAS char*)K_lds; LAS char* V_las = (LAS char*)V_lds;
#define DMA_K(j_, b_) do { const char* kb_ = (const char*)Kh + (size_t)(j_) * (64 * LD * 2); _Pragma("unroll") for (int i = 0; i < 4; ++i) \
    __builtin_amdgcn_global_load_lds((const unsigned*)(kb_ + kgo[i]), (LAS unsigned*)(K_las + (b_) * 16384 + (4 * a + i) * 1024), 16, 0, 0); } while (0)
#define DMA_V(j_, b_) do { const char* vb_ = (const char*)Vh + (size_t)(j_) * (64 * LD * 2); _Pragma("unroll") for (int hf = 0; hf < 2; ++hf) _Pragma("unroll") for (int i = 0; i < 4; ++i) \
    __builtin_amdgcn_global_load_lds((const unsigned*)(vb_ + hf * 256 + vgo[i]), (LAS unsigned*)(V_las + (b_) * 32768 + hf * 16384 + (4 * a + i) * 1024), 16, 0, 0); } while (0)
  if (!isA) DMA_K(0, 0);
  asm volatile("s_waitcnt vmcnt(0)" ::: "memory");
  __syncthreads();
  if (isA) {
    float m_reg = -1e30f, l_reg = 0; bf16x8 qr[8];
    const bf16* Qw = Qb + (long)(a * QBLK + r32) * LD + hi * 8;
#pragma unroll
    for (int d0 = 0; d0 < 8; ++d0) qr[d0] = *reinterpret_cast<const bf16x8*>(Qw + d0 * 16);
    for (int j = 0; j <= NT; ++j) {
      if (j < NT) {
        f32x16 p0, p1; float mn, al; bf16x8 pa0, pa1, pa2, pa3;
        __builtin_amdgcn_s_setprio(3);
        qkt(p0, p1, K_lds + (j & 1) * 16384, qr, r32, hi);
        fix_prompt(p0, p1, j, lim, qrow0, r32, hi, lut);
        partialSM(p0, p1, m_reg, mn, al);
        finishSM(p0, p1, al, l_reg, pa0, pa1, pa2, pa3);
        __builtin_amdgcn_s_setprio(0);
        char* ps = P_lds + (j & 1) * 16384 + lane * 16;
        *(bf16x8*)(ps) = pa0; *(bf16x8*)(ps + 1024) = pa1; *(bf16x8*)(ps + 2048) = pa2; *(bf16x8*)(ps + 3072) = pa3;
        if (hi == 0) alpha_l[(j & 1) * 128 + r32] = al;
      }
      __syncthreads();
    }
    if (hi == 0) l_l[r32] = l_reg;
    __syncthreads();
  } else {
    const int rp = a >> 1, ch = a & 1;
    const char* P0 = lds + 98304 + (2 * rp) * 4096; const float* al0 = scr + (2 * rp) * 32; const float* ll0 = scr + 256 + (2 * rp) * 32;
    f32x16 o[2][4] = {};
    for (int j = 0; j <= NT; ++j) {
      if (j + 1 < NT) DMA_K(j + 1, (j + 1) & 1);
      if (j < NT) DMA_V(j, j & 1);
      if (j >= 1) {
        const float* al = al0 + ((j - 1) & 1) * 128;
        if (__any(al[r32] < 1.f) || __any(al[32 + r32] < 1.f)) {
#pragma unroll
          for (int rb = 0; rb < 2; ++rb)
#pragma unroll
            for (int d = 0; d < 4; ++d)
#pragma unroll
              for (int r = 0; r < 16; ++r) o[rb][d][r] *= al[rb * 32 + crow(r, hi)]; }
        const char* ps = P0 + ((j - 1) & 1) * 16384 + lane * 16;
        const bf16x8 pa0 = *(const bf16x8*)(ps), pa1 = *(const bf16x8*)(ps + 1024), pa2 = *(const bf16x8*)(ps + 2048), pa3 = *(const bf16x8*)(ps + 3072);
        const bf16x8 pb0 = *(const bf16x8*)(ps + 4096), pb1 = *(const bf16x8*)(ps + 4096 + 1024), pb2 = *(const bf16x8*)(ps + 4096 + 2048), pb3 = *(const bf16x8*)(ps + 4096 + 3072);
        const int vb = vrb + ((j - 1) & 1) * 32768 + ch * 16384;
        pv_two<0>(o[0][0], o[1][0], vb, pa0, pa1, pa2, pa3, pb0, pb1, pb2, pb3); pv_two<1>(o[0][1], o[1][1], vb, pa0, pa1, pa2, pa3, pb0, pb1, pb2, pb3);
        pv_two<2>(o[0][2], o[1][2], vb, pa0, pa1, pa2, pa3, pb0, pb1, pb2, pb3); pv_two<3>(o[0][3], o[1][3], vb, pa0, pa1, pa2, pa3, pb0, pb1, pb2, pb3);
      }
      asm volatile("s_waitcnt vmcnt(0)" ::: "memory");
      __syncthreads();
    }
    __syncthreads();
#pragma unroll
    for (int rb = 0; rb < 2; ++rb) {
      float rli[16];
#pragma unroll
      for (int r = 0; r < 16; ++r) rli[r] = __builtin_amdgcn_rcpf(ll0[rb * 32 + crow(r, hi)]);
      bf16* Ow = Ob + (long)(64 * rp + 32 * rb) * LD + ch * 128;
#pragma unroll
      for (int r = 0; r < 16; ++r) { const int orow = crow(r, hi);
#pragma unroll
        for (int d0 = 0; d0 < 4; ++d0) { const unsigned w_ = cvt_pk_bf16(o[rb][d0][r] * rli[r], 0.f); Ow[(long)orow * LD + d0 * 32 + r32] = (bf16)(w_ & 0xffffu); } } }
  }
#undef DMA_K
#undef DMA_V
}

__device__ __forceinline__ void attn_sample_unit(int b, int h, int split, const bf16* __restrict__ Q, const float* __restrict__ cache_k, const float* __restrict__ cache_v,
                                                 const float* __restrict__ newk, const float* __restrict__ newv, float* __restrict__ part, const float* lut, char* lds, float* scr) {
  const int tid = opaque_tid(), wid = __builtin_amdgcn_readfirstlane(tid >> 6), lane = tid & 63, r32 = lane & 31, hi = lane >> 5;
  const int nT = split ? 33 : 32;
  if (wid >= 4) {
    const int lw = wid - 4;
    f32x4 kreg[16], vreg[16];
#define SL_LOAD(j) do { const bool isnew = ((j) == 32); \
      const float* kp = isnew ? newk + ((size_t)b * 16 + lw) * 2048 + h * 256 + lane * 4 : cache_k + ((size_t)b * 4096 + (size_t)split * 2048 + (size_t)(j) * 64 + lw) * 2048 + h * 256 + lane * 4; \
      const float* vp = isnew ? newv + ((size_t)b * 16 + lw) * 2048 + h * 256 + lane * 4 : cache_v + ((size_t)b * 4096 + (size_t)split * 2048 + (size_t)(j) * 64 + lw) * 2048 + h * 256 + lane * 4; \
      _Pragma("unroll") for (int i = 0; i < 16; ++i) { \
        if (!isnew || i < 4) { kreg[i] = __builtin_nontemporal_load(reinterpret_cast<const f32x4*>(kp)); vreg[i] = __builtin_nontemporal_load(reinterpret_cast<const f32x4*>(vp)); } \
        else { kreg[i] = (f32x4){0.f, 0.f, 0.f, 0.f}; vreg[i] = (f32x4){0.f, 0.f, 0.f, 0.f}; } \
        kp += 4 * 2048; vp += 4 * 2048; asm volatile("" : "+v"(kp), "+v"(vp)); } } while (0)
#define SL_WRITE(bufi) do { char* bb = lds + (bufi) * 65536; _Pragma("unroll") for (int i = 0; i < 16; ++i) { const int key = i * 4 + lw; \
      const int c = lane >> 5, db = (lane & 31) * 8; \
      u32x2 kw; kw.x = cvt_pk_bf16(kreg[i][0], kreg[i][1]); kw.y = cvt_pk_bf16(kreg[i][2], kreg[i][3]); \
      *reinterpret_cast<u32x2*>(bb + c * 16384 + KSWZ(key, db & ~15) + (db & 15)) = kw; \
      const int e = lane * 4, vh = e >> 7, cc = e & 127; \
      u32x2 vw; vw.x = cvt_pk_bf16(vreg[i][0], vreg[i][1]); vw.y = cvt_pk_bf16(vreg[i][2], vreg[i][3]); \
      *reinterpret_cast<u32x2*>(bb + 32768 + vh * 16384 + v_st(key, cc & ~7) + (cc & 7) * 2) = vw; } } while (0)
    SL_LOAD(0); SL_WRITE(0); SL_LOAD(1);
    __syncthreads();
    for (int j = 0; j < nT; ++j) {
      if (j + 1 < nT) { SL_WRITE((j + 1) & 1); if (j + 2 < nT) SL_LOAD(j + 2); }
      __syncthreads();
    }
#undef SL_LOAD
#undef SL_WRITE
  } else {
    const int c = wid & 1, vh = wid >> 1;
    float* li_l = scr + wid * 64; float* al_l = li_l + 32;
    float m_reg = -1e30f, l_reg = 0; f32x16 o[4] = {};
    const bf16* Qw = Q + (size_t)(MP + b * 16 + (r32 & 15)) * LD + h * 256 + c * 128 + hi * 8;
    __syncthreads();
    for (int j = 0; j < nT; ++j) {
      char* bb = lds + (j & 1) * 65536;
      f32x16 p0, p1; float mn, al; bf16x8 pa0, pa1, pa2, pa3; bf16x8 qr[8];
      asm volatile("" : "+v"(Qw));
#pragma unroll
      for (int d0 = 0; d0 < 8; ++d0) { bf16x8 v = *reinterpret_cast<const bf16x8*>(Qw + d0 * 16); if (r32 >= 16) v = (bf16x8){0, 0, 0, 0, 0, 0, 0, 0}; qr[d0] = v; }
      qkt(p0, p1, bb + c * 16384, qr, r32, hi);
      const int kbase = (j == 32) ? 4096 : split * 2048 + j * 64;
      if (kbase >= 3904) {
        const float* lp = lut + (kbase - (4096 + r32) + 192);
#pragma unroll
        for (int r = 0; r < 16; ++r) { p0[r] += lp[crow(r, hi)]; p1[r] += lp[32 + crow(r, hi)]; }
      }
      if (j == 32) {
#pragma unroll
        for (int r = 0; r < 16; ++r) { if (crow(r, hi) >= 16) p0[r] = -1e30f; p1[r] = -1e30f; }
      }
      partialSM(p0, p1, m_reg, mn, al);
      RESC(al);
      finishSM(p0, p1, al, l_reg, pa0, pa1, pa2, pa3); SBAR();
      pv_d0(o, (int)(uintptr_t)(bb + 32768 + vh * 16384) + v_rd_base(lane), pa0, pa1, pa2, pa3);
      __syncthreads();
    }
    float* pp = part + (size_t)((((b * 8 + h) * 2 + split) * 4) + c * 2 + vh) * 2112;
    if (hi == 0 && r32 < 16) { pp[r32] = m_reg; pp[16 + r32] = l_reg; }
#pragma unroll
    for (int d0 = 0; d0 < 4; ++d0)
#pragma unroll
      for (int r = 0; r < 8; ++r) pp[64 + crow(r, hi) * 128 + d0 * 32 + r32] = o[d0][r];
  }
#undef RESC
}
}

namespace hg {
constexpr int QG_OFF = 0, KG_OFF = 8704, KDT_OFF = 17408, DL_OFF = 25600, SSQP_OFF = 26624, ROWB = 272, RAW_OFF = 28672, RAW_SLOT = 20480;
__device__ __forceinline__ void row_prefix4(float x, int tq, float& pre, float& tot) {
    const auto s16 = __builtin_amdgcn_permlane16_swap(__float_as_uint(x), __float_as_uint(x), false, false);
    const float ev = __uint_as_float(s16[0]), od = __uint_as_float(s16[1]), pr = ev + od;
    const auto s32 = __builtin_amdgcn_permlane32_swap(__float_as_uint(pr), __float_as_uint(pr), false, false);
    const float lo = __uint_as_float(s32[0]), hi = __uint_as_float(s32[1]);
    tot = lo + hi; pre = tq == 0 ? 0.f : tq == 1 ? ev : tq == 2 ? lo : lo + ev;
}
template <bool FULL>
__device__ __forceinline__ void hgrn_prep(char* lds, int s, int w, int kc, int tq, int kpos, float& gsum, s16x4& vfrag, u32x2& gvp) {
    const int buf = s & 1;
    char* QG = lds + QG_OFF + buf * 4352; char* KG = lds + KG_OFF + buf * 4352; char* KDT = lds + KDT_OFF + buf * 4096;
    float* DL = (float*)(lds + DL_OFF + buf * 512);
    const char* raw = lds + RAW_OFF + buf * RAW_SLOT;
    float lf[4]; unsigned short qv[4], vv[4], gv[4];
#pragma unroll
    for (int j = 0; j < 4; ++j) { const int e = (4 * tq + j) * 128 + 16 * w + kc; lf[j] = h2f(*(const unsigned short*)(raw + e * 2)); vv[j] = *(const unsigned short*)(raw + 12288 + e * 2);
        if (FULL) { qv[j] = *(const unsigned short*)(raw + 8192 + e * 2); gv[j] = *(const unsigned short*)(raw + 16384 + e * 2); } }
    float G[4], glast;
    { const float c0 = lf[0], c1 = c0 + lf[1], c2 = c1 + lf[2], c3 = c2 + lf[3];
      float pre; row_prefix4(c3, tq, pre, glast);
      G[0] = pre + c0; G[1] = pre + c1; G[2] = pre + c2; G[3] = pre + c3; }
    float kd[4];
#pragma unroll
    for (int j = 0; j < 4; ++j) { const float kk = 1.f - __builtin_amdgcn_exp2f(lf[j]);
        kd[j] = kk * __builtin_amdgcn_exp2f(glast - G[j]);
        if (FULL) { const float qg = bf2f(qv[j]) * __builtin_amdgcn_exp2f(G[j]), kg = kk * __builtin_amdgcn_exp2f(fminf(-G[j], 115.f));
            const unsigned qk = cvt_pk_bf16(qg, kg);
            *(bf16*)(QG + (4 * tq + j) * ROWB + kpos * 2) = (bf16)(qk & 0xffffu);
            *(bf16*)(KG + (4 * tq + j) * ROWB + kpos * 2) = (bf16)(qk >> 16); }
        vfrag[j] = (short)vv[j]; }
    { u32x2 kw; kw.x = cvt_pk_bf16(kd[0], kd[1]); kw.y = cvt_pk_bf16(kd[2], kd[3]); *(u32x2*)(KDT + ((16 * w + kc) * 16 + 4 * tq) * 2) = kw; }
    DL[16 * w + kc] = __builtin_amdgcn_exp2f(glast);
    gsum += glast;
    if (FULL) { gvp.x = (unsigned)gv[0] | ((unsigned)gv[1] << 16); gvp.y = (unsigned)gv[2] | ((unsigned)gv[3] << 16); }
}
template <bool FULL>
__device__ __forceinline__ void hgrn_mma(char* lds, int s, int w, int kc, int tq, const s16x4 vfrag, f32x4 (&S)[8], f32x4& o) {
    const int buf = s & 1;
    const char* QG = lds + QG_OFF + buf * 4352; const char* KG = lds + KG_OFF + buf * 4352; const char* KDT = lds + KDT_OFF + buf * 4096;
    const float* DL = (const float*)(lds + DL_OFF + buf * 512); float* SSQP = (float*)(lds + SSQP_OFF + buf * 512);
    o = (f32x4){0.f, 0.f, 0.f, 0.f};
    if (FULL) {
        f32x4 st = {0.f, 0.f, 0.f, 0.f};
#pragma unroll
        for (int ks = 0; ks < 4; ++ks) {
            const bf16x8 qa = *(const bf16x8*)(QG + kc * ROWB + (32 * ks + 8 * tq) * 2), ka = *(const bf16x8*)(KG + kc * ROWB + (32 * ks + 8 * tq) * 2);
            u32x4 sw; sw.x = cvt_pk_bf16(S[2 * ks][0], S[2 * ks][1]); sw.y = cvt_pk_bf16(S[2 * ks][2], S[2 * ks][3]);
            sw.z = cvt_pk_bf16(S[2 * ks + 1][0], S[2 * ks + 1][1]); sw.w = cvt_pk_bf16(S[2 * ks + 1][2], S[2 * ks + 1][3]);
            o = __builtin_amdgcn_mfma_f32_16x16x32_bf16(qa, *reinterpret_cast<bf16x8*>(&sw), o, 0, 0, 0);
            st = __builtin_amdgcn_mfma_f32_16x16x32_bf16(ka, qa, st, 0, 0, 0); }
#pragma unroll
        for (int i = 0; i < 4; ++i) st[i] = (4 * tq + i <= kc) ? st[i] : 0.f;
        u32x2 sp; sp.x = cvt_pk_bf16(st[0], st[1]); sp.y = cvt_pk_bf16(st[2], st[3]);
        o = __builtin_amdgcn_mfma_f32_16x16x16bf16_1k(*reinterpret_cast<s16x4*>(&sp), vfrag, o, 0, 0, 0);
    }
#pragma unroll
    for (int kb = 0; kb < 8; ++kb) { const f32x4 dlv = *(const f32x4*)(DL + 16 * kb + 4 * tq);
        const s16x4 ka = *(const s16x4*)(KDT + ((16 * kb + kc) * 16 + 4 * tq) * 2);
        S[kb] = __builtin_amdgcn_mfma_f32_16x16x16bf16_1k(ka, vfrag, S[kb] * dlv, 0, 0, 0); }
    if (FULL) {
        float ss[4];
#pragma unroll
        for (int i = 0; i < 4; ++i) ss[i] = row16_sum(o[i] * o[i]);
#pragma unroll
        for (int i = 0; i < 4; ++i) SSQP[(4 * tq + i) * 8 + w] = ss[i];
    }
}
__device__ __forceinline__ void hgrn_fin(char* lds, int s, int w, int kc, int tq, int ch, int row0, float gn, const f32x4 o, const u32x2 gvp, bf16* __restrict__ O) {
    const float* SSQP = (const float*)(lds + SSQP_OFF + (s & 1) * 512);
#pragma unroll
    for (int i = 0; i < 4; ++i) { const float part = SSQP[(4 * tq + i) * 8 + (kc & 7)];
        const float tot = row16_sum(kc < 8 ? part : 0.f);
        const float rs = __builtin_amdgcn_rsqf(tot * (1.f / 128.f) + EPS);
        const unsigned gw_ = i < 2 ? gvp.x : gvp.y; const float gate = __uint_as_float((i & 1) ? (gw_ & 0xffff0000u) : (gw_ << 16));
        const float ov = o[i] * rs * gn * gate;
        O[(size_t)(row0 + 16 * s + 4 * tq + i) * D + ch] = (bf16)(cvt_pk_bf16(ov, 0.f) & 0xffffu); }
}
template <bool FULL, bool SBF>
__device__ __forceinline__ void hgrn_item(const bf16* __restrict__ Q, const float* __restrict__ LOGF, const bf16* __restrict__ V, const bf16* __restrict__ GS, bf16* __restrict__ O,
                                          int row0, int nsteps, int h, const void* __restrict__ Sin, void* __restrict__ Sout, float* __restrict__ Dout, const float* __restrict__ gain, char* lds) {
    const int tid = opaque_tid(), w = __builtin_amdgcn_readfirstlane(tid >> 6), lane = tid & 63, kc = lane & 15, tq = lane >> 4;
    const int ch = h * 128 + 16 * w + kc;
    const int kpos = 32 * (w >> 1) + 8 * (kc >> 2) + 4 * (w & 1) + (kc & 3);
    f32x4 S[8];
#pragma unroll
    for (int kb = 0; kb < 8; ++kb)
#pragma unroll
        for (int i = 0; i < 4; ++i) { const size_t so = (size_t)(16 * kb + 4 * tq + i) * 128 + 16 * w + kc; S[kb][i] = Sin ? (SBF ? bf2f(((const bf16*)Sin)[so]) : ((const float*)Sin)[so]) : 0.f; }
    float gsum = 0.f;
    const int t2 = tid & 255; const bool lo4 = tid < 256;
    const unsigned short* plf = (const unsigned short*)LOGF + (size_t)(row0 + (tid >> 5)) * D + h * 128 + 4 * (tid & 31);
    const size_t boff = (size_t)(row0 + (t2 >> 4)) * D + h * 128 + 8 * (t2 & 15);
    const bf16* pb0 = (lo4 ? Q : V) + boff; const bf16* pb1 = GS + boff;
    u32x2 rl[3]; bf16x8 rb0[3], rb1[3];
#define HG_LOAD(j, s_) do { rl[j] = *(const u32x2*)(plf + (size_t)(s_) * 16 * D); if (FULL || !lo4) rb0[j] = *(const bf16x8*)(pb0 + (size_t)(s_) * 16 * D); if (FULL && lo4) rb1[j] = *(const bf16x8*)(pb1 + (size_t)(s_) * 16 * D); } while (0)
#define HG_WRITE(j, slot) do { char* rb = lds + RAW_OFF + (slot) * RAW_SLOT; *(u32x2*)(rb + tid * 8) = rl[j]; \
        if (lo4) { if (FULL) { *(bf16x8*)(rb + 8192 + t2 * 16) = rb0[j]; *(bf16x8*)(rb + 16384 + t2 * 16) = rb1[j]; } } else *(bf16x8*)(rb + 12288 + t2 * 16) = rb0[j]; } while (0)
    const float gn = FULL ? gain[16 * w + kc] : 0.f;
    s16x4 vf_cur, vf_nxt; u32x2 gv_cur = {0u, 0u}, gv_nxt = {0u, 0u}, gv_prev = {0u, 0u}; f32x4 o_prev = {0.f, 0.f, 0.f, 0.f};
    HG_LOAD(0, 0); if (1 < nsteps) HG_LOAD(1, 1); if (2 < nsteps) HG_LOAD(2, 2);
    HG_WRITE(0, 0); if (1 < nsteps) HG_WRITE(1, 1);
    if (3 < nsteps) HG_LOAD(0, 3); if (4 < nsteps) HG_LOAD(1, 4);
    LDS_WAIT(); __builtin_amdgcn_s_barrier(); asm volatile("" ::: "memory");
    hgrn_prep<FULL>(lds, 0, w, kc, tq, kpos, gsum, vf_cur, gv_cur);
    LDS_WAIT(); __builtin_amdgcn_s_barrier(); asm volatile("" ::: "memory");
#define HG_STEP(j) do { const int s = s3 + (j); if (s < nsteps) { f32x4 o_s; \
        hgrn_mma<FULL>(lds, s, w, kc, tq, vf_cur, S, o_s); \
        if (s + 1 < nsteps) hgrn_prep<FULL>(lds, s + 1, w, kc, tq, kpos, gsum, vf_nxt, gv_nxt); \
        if (FULL && s >= 1) hgrn_fin(lds, s - 1, w, kc, tq, ch, row0, gn, o_prev, gv_prev, O); \
        if (s + 2 < nsteps) HG_WRITE(((j) + 2) % 3, s & 1); \
        if (s + 5 < nsteps) HG_LOAD(((j) + 2) % 3, s + 5); \
        LDS_WAIT(); __builtin_amdgcn_s_barrier(); asm volatile("" ::: "memory"); \
        o_prev = o_s; gv_prev = gv_cur; vf_cur = vf_nxt; gv_cur = gv_nxt; } } while (0)
#pragma unroll 1
    for (int s3 = 0; s3 < nsteps; s3 += 3) { HG_STEP(0); HG_STEP(1); HG_STEP(2); }
    if (FULL) hgrn_fin(lds, nsteps - 1, w, kc, tq, ch, row0, gn, o_prev, gv_prev, O);
    if (Sout) {
#pragma unroll
        for (int kb = 0; kb < 8; ++kb)
#pragma unroll
            for (int i = 0; i < 4; ++i) { const size_t so = (size_t)(16 * kb + 4 * tq + i) * 128 + 16 * w + kc; if (SBF) ((bf16*)Sout)[so] = (bf16)(cvt_pk_bf16(S[kb][i], 0.f) & 0xffffu); else ((float*)Sout)[so] = S[kb][i]; } }
    if (!FULL && Dout && tq == 0) Dout[16 * w + kc] = __builtin_amdgcn_exp2f(gsum);
    LDS_WAIT(); __builtin_amdgcn_s_barrier(); asm volatile("" ::: "memory");
#undef HG_LOAD
#undef HG_WRITE
#undef HG_STEP
}
__device__ __forceinline__ void hgrn_prep64(char* lds, int s, int w, int kc, int tq, float& gsum, bf16x8 (&vf)[2]) {
    const int buf = s & 1; const char* raw = lds + buf * 49152; char* KDT = lds + 98304 + buf * 16384; float* DL = (float*)(lds + 131072 + buf * 512);
    const int ch = 16 * w + kc;
    float lf[2][8];
#pragma unroll
    for (int hf = 0; hf < 2; ++hf)
#pragma unroll
        for (int jj = 0; jj < 8; ++jj) { const int t = 32 * hf + 8 * tq + jj; lf[hf][jj] = h2f(*(const unsigned short*)(raw + (t * 128 + ch) * 2));
            vf[hf][jj] = (short)*(const unsigned short*)(raw + 32768 + (t * 128 + ch) * 2); }
    float c[2][8];
#pragma unroll
    for (int hf = 0; hf < 2; ++hf) { c[hf][0] = lf[hf][0];
#pragma unroll
        for (int jj = 1; jj < 8; ++jj) c[hf][jj] = c[hf][jj - 1] + lf[hf][jj]; }
    const float R0 = c[0][7], R1 = c[1][7];
    float P0, T0, p1_, t1_; row_prefix4(R0, tq, P0, T0); row_prefix4(R1, tq, p1_, t1_);
    const float P1 = T0 + p1_, glast = T0 + t1_;
#pragma unroll
    for (int hf = 0; hf < 2; ++hf) { const float P = hf ? P1 : P0; float kd[8];
#pragma unroll
        for (int jj = 0; jj < 8; ++jj) kd[jj] = (1.f - __builtin_amdgcn_exp2f(lf[hf][jj])) * __builtin_amdgcn_exp2f(glast - (P + c[hf][jj]));
        u32x4 kw; kw.x = cvt_pk_bf16(kd[0], kd[1]); kw.y = cvt_pk_bf16(kd[2], kd[3]); kw.z = cvt_pk_bf16(kd[4], kd[5]); kw.w = cvt_pk_bf16(kd[6], kd[7]);
        *(u32x4*)(KDT + ch * 128 + (((4 * hf + tq) ^ (ch & 7)) << 4)) = kw; }
    DL[ch] = __builtin_amdgcn_exp2f(glast);
    gsum += glast;
}
__device__ __forceinline__ void hgrn_mma64(char* lds, int s, int kc, int tq, const bf16x8 (&vf)[2], f32x4 (&S)[8]) {
    const int buf = s & 1; const char* KDT = lds + 98304 + buf * 16384; const float* DL = (const float*)(lds + 131072 + buf * 512);
#pragma unroll
    for (int kb = 0; kb < 8; ++kb) { const f32x4 dlv = *(const f32x4*)(DL + 16 * kb + 4 * tq); const int kr = 16 * kb + kc;
        const bf16x8 k0 = *(const bf16x8*)(KDT + kr * 128 + ((tq ^ (kr & 7)) << 4)), k1 = *(const bf16x8*)(KDT + kr * 128 + (((4 + tq) ^ (kr & 7)) << 4));
        f32x4 acc = S[kb] * dlv;
        acc = __builtin_amdgcn_mfma_f32_16x16x32_bf16(k0, vf[0], acc, 0, 0, 0);
        S[kb] = __builtin_amdgcn_mfma_f32_16x16x32_bf16(k1, vf[1], acc, 0, 0, 0); }
}
__device__ __forceinline__ void hgrn_state_item64(const float* __restrict__ LOGF, const bf16* __restrict__ V, int row0, int nsteps, int h, bf16* __restrict__ Sout, float* __restrict__ Dout, char* lds) {
    const int tid = opaque_tid(), w = __builtin_amdgcn_readfirstlane(tid >> 6), lane = tid & 63, kc = lane & 15, tq = lane >> 4;
    f32x4 S[8];
#pragma unroll
    for (int kb = 0; kb < 8; ++kb) S[kb] = (f32x4){0.f, 0.f, 0.f, 0.f};
    float gsum = 0.f;
    const char* glf = (const char*)((const unsigned short*)LOGF + (size_t)(row0 + 8 * w + (lane >> 4)) * D + h * 128 + 8 * (lane & 15));
    const char* gv = (const char*)(V + (size_t)(row0 + 8 * w + (lane >> 4)) * D + h * 128 + 8 * (lane & 15));
    LAS char* ll = (LAS char*)lds;
#define HG_DMA(s_, slot) do { _Pragma("unroll") for (int i = 0; i < 2; ++i) \
        __builtin_amdgcn_global_load_lds((const unsigned*)(glf + ((size_t)(s_) * 64 + 4 * i) * (D * 2)), (LAS unsigned*)(ll + (slot) * 49152 + (8 * w + 4 * i) * 256), 16, 0, 0); \
      _Pragma("unroll") for (int i = 0; i < 2; ++i) \
        __builtin_amdgcn_global_load_lds((const unsigned*)(gv + ((size_t)(s_) * 64 + 4 * i) * (D * 2)), (LAS unsigned*)(ll + (slot) * 49152 + 32768 + (8 * w + 4 * i) * 256), 16, 0, 0); } while (0)
    bf16x8 vf_cur[2], vf_nxt[2];
    HG_DMA(0, 0); if (1 < nsteps) HG_DMA(1, 1);
    asm volatile("s_waitcnt vmcnt(0)" ::: "memory"); __builtin_amdgcn_s_barrier(); asm volatile("" ::: "memory");
    hgrn_prep64(lds, 0, w, kc, tq, gsum, vf_cur);
    LDS_WAIT(); __builtin_amdgcn_s_barrier(); asm volatile("" ::: "memory");
#pragma unroll 1
    for (int s = 0; s < nsteps; ++s) {
        if (s + 2 < nsteps) HG_DMA(s + 2, s & 1);
        hgrn_mma64(lds, s, kc, tq, vf_cur, S);
        if (s + 1 < nsteps) hgrn_prep64(lds, s + 1, w, kc, tq, gsum, vf_nxt);
        asm volatile("s_waitcnt vmcnt(0) lgkmcnt(0)" ::: "memory"); __builtin_amdgcn_s_barrier(); asm volatile("" ::: "memory");
        vf_cur[0] = vf_nxt[0]; vf_cur[1] = vf_nxt[1];
    }
#undef HG_DMA
#pragma unroll
    for (int kb = 0; kb < 8; ++kb)
#pragma unroll
        for (int i = 0; i < 4; ++i) Sout[(size_t)(16 * kb + 4 * tq + i) * 128 + 16 * w + kc] = (bf16)(cvt_pk_bf16(S[kb][i], 0.f) & 0xffffu);
    if (tq == 0) Dout[16 * w + kc] = __builtin_amdgcn_exp2f(gsum);
    LDS_WAIT(); __builtin_amdgcn_s_barrier(); asm volatile("" ::: "memory");
}
}

__device__ __forceinline__ float row_scale_any(const float* ssq, const float* ssqS, int row) { return row < MP ? pg8::row_scale(ssq, row) : sk::row_scale_s(ssqS, row - MP); }
__device__ __forceinline__ f32x4 ldx4(const bf16* p) { const u32x2 w = *(const u32x2*)p; return (f32x4){__uint_as_float(w.x << 16), __uint_as_float(w.x & 0xffff0000u), __uint_as_float(w.y << 16), __uint_as_float(w.y & 0xffff0000u)}; }
template <int W>
__device__ __forceinline__ void pool_tile(const bf16* __restrict__ X, const float* __restrict__ ssq, const float* __restrict__ ssqS, const float* __restrict__ gain, const float* __restrict__ hist, int histmode,
                                          int xrow0, int nt, int pos0, bf16* __restrict__ P, float* __restrict__ newpool, int np_first, int c4) {
    const f32x4 gv = *(const f32x4*)(gain + c4);
    f32x4 ring[16], wsum = {0.f, 0.f, 0.f, 0.f};
#pragma unroll
    for (int i = 0; i < 16; ++i) ring[i] = (f32x4){0.f, 0.f, 0.f, 0.f};
#pragma unroll
    for (int i = 1; i < 16; ++i) { const int r = -16 + i; f32x4 val = {0.f, 0.f, 0.f, 0.f};
        if (histmode == 0) { const int row = xrow0 + r; const float rs = row_scale_any(ssq, ssqS, row); val = ldx4(X + (size_t)row * D + c4) * rs * gv; }
        else if (histmode == 2) val = *(const f32x4*)(hist + (size_t)(r + 15) * D + c4);
        wsum += val - ring[(i - W + 16) & 15]; ring[i] = val; }
    for (int blk = 0; blk < nt / 16; ++blk) {
#pragma unroll
        for (int i = 0; i < 16; ++i) { const int r = 16 * blk + i, row = xrow0 + r; const float rs = row_scale_any(ssq, ssqS, row);
            const f32x4 val = ldx4(X + (size_t)row * D + c4) * rs * gv;
            wsum += val - ring[(i - W + 16) & 15]; ring[i] = val;
            const int cnt = (pos0 + r + 1) < W ? (pos0 + r + 1) : W; const float ic = 1.0f / (float)cnt;
            const f32x4 pv = wsum * ic - val;
            u32x2 pw; pw.x = cvt_pk_bf16(pv[0], pv[1]); pw.y = cvt_pk_bf16(pv[2], pv[3]);
            *(u32x2*)(P + (size_t)row * D + c4) = pw;
            if (newpool && r >= np_first) *(f32x4*)(newpool + (size_t)(r - np_first) * D + c4) = val; }
    }
}

#define XB_TMO      128
#define XB_XCNT(j)  (256  + 64 * (j))
#define XB_XSUB(j)  (1280 + 64 * (j))
#define XB_XGEN(j)  (2304 + 64 * (j))
#define XB_TOP      3328
#define XB_TOPGEN   3392
#define XCD_BAR_WORDS 3456
#define XB_SPIN_CAP (1u << 18)
__device__ __forceinline__ unsigned xb_ld(unsigned* p)              { return __hip_atomic_load(p, __ATOMIC_RELAXED, __HIP_MEMORY_SCOPE_AGENT); }
__device__ __forceinline__ unsigned xb_add(unsigned* p, unsigned v) { return __hip_atomic_fetch_add(p, v, __ATOMIC_RELAXED, __HIP_MEMORY_SCOPE_AGENT); }
__device__ __forceinline__ unsigned xb_xcc_id() { return (unsigned)__builtin_amdgcn_s_getreg((3 << 11) | 20) & 0xFu; }
#define XB_SPIN(cond, bar) do { unsigned _sp = 0; while (cond) { __builtin_amdgcn_s_sleep(1); \
    if ((++_sp & 255u) == 0u) { if (xb_ld(&(bar)[XB_TMO])) break; if (_sp > XB_SPIN_CAP) { atomicAdd(&(bar)[XB_TMO], 1u); break; } } } } while (0)
struct XcdBarrier { unsigned* bar; unsigned x; volatile LAS unsigned* st; };
__device__ __forceinline__ XcdBarrier xcd_barrier_post(unsigned* bar, volatile LAS unsigned* st) {
    XcdBarrier b; b.bar = bar; b.x = xb_xcc_id(); b.st = st;
    if (threadIdx.x == 0) (void)xb_add(&bar[XB_XCNT(b.x)], 1u);
    return b;
}
__device__ __forceinline__ void xcd_barrier_complete(unsigned* bar, unsigned x, unsigned& nloc, unsigned& nx) {
    const unsigned G = gridDim.x * gridDim.y * gridDim.z;
    unsigned sum, cnt, mine, sp = 0u;
    for (;;) {
        sum = 0u; cnt = 0u; mine = 0u;
#pragma unroll
        for (unsigned j = 0; j < 16; ++j) { const unsigned c = xb_ld(&bar[XB_XCNT(j)]); sum += c; cnt += (c > 0u) ? 1u : 0u; mine = (j == x) ? c : mine; }
        if (sum == G) break;
        __builtin_amdgcn_s_sleep(1);
        if ((++sp & 255u) == 0u) { if (xb_ld(&bar[XB_TMO])) break; if (sp > XB_SPIN_CAP) { atomicAdd(&bar[XB_TMO], 1u); break; } }
    }
    nloc = mine > 0u ? mine : 1u; nx = cnt > 0u ? cnt : 1u;
}
__device__ __forceinline__ void xcd_barrier(const XcdBarrier& b) {
    asm volatile("s_waitcnt vmcnt(0)" ::: "memory");
    __syncthreads();
    if (threadIdx.x == 0) {
        unsigned* bar = b.bar;
        __builtin_amdgcn_s_waitcnt(0);
        unsigned nloc = b.st[0], nx = b.st[1];
        if (nloc == 0u) { xcd_barrier_complete(bar, b.x, nloc, nx); b.st[0] = nloc; b.st[1] = nx; }
        const unsigned old = xb_add(&bar[XB_XSUB(b.x)], 1u);
        const unsigned gen = old / nloc;
        if (old + 1u == (gen + 1u) * nloc) {
            __builtin_amdgcn_fence(__ATOMIC_RELEASE, "agent");
            asm volatile("s_waitcnt vmcnt(0)" ::: "memory");
            const unsigned og = xb_add(&bar[XB_TOP], 1u);
            const unsigned tg = og / nx;
            if (og + 1u == (tg + 1u) * nx) xb_add(&bar[XB_TOPGEN], 1u);
            else XB_SPIN(xb_ld(&bar[XB_TOPGEN]) == tg, bar);
            __builtin_amdgcn_fence(__ATOMIC_ACQUIRE, "agent");
            xb_add(&bar[XB_XGEN(b.x)], 1u);
            asm volatile("s_waitcnt vmcnt(0)" ::: "memory");
        } else {
            XB_SPIN(xb_ld(&bar[XB_XGEN(b.x)]) == gen, bar);
            __builtin_amdgcn_fence(__ATOMIC_ACQUIRE, "agent");
            asm volatile("s_waitcnt vmcnt(0)" ::: "memory");
        }
    }
    __syncthreads();
}

struct Args { const float* in[31]; float* out; unsigned char* ws; int lo, hi; };
enum { I_XP = 0, I_XS, I_SHG, I_SPL, I_CK, I_CV, I_NMIX, I_NFFN, I_NFIN, I_HWQ, I_HWF, I_HWI, I_HWG, I_HWO, I_HLB, I_HGAIN, I_PW, I_PSC, I_AWQ, I_AWK, I_AWV, I_AWO,
       I_LQ1, I_LK1, I_LQ2, I_LK2, I_SUBG, I_REL, I_FG, I_FU, I_FD };
constexpr int PH_END = 42;

__device__ __forceinline__ void cvt_item(const float* __restrict__ W, int N, bf16* __restrict__ WT, int K, int k0, int n0, int drow, const float* __restrict__ gain, LAS float* scr, int lane) {
    const int sub = lane >> 3, ch = lane & 7;
    f32x4 v[8];
#pragma unroll
    for (int i = 0; i < 8; ++i) v[i] = *(const f32x4*)(W + (size_t)(k0 + 8 * i + sub) * N + n0 + 4 * ch);
#pragma unroll
    for (int i = 0; i < 8; ++i) { const int kk = 8 * i + sub; const float gm = gain ? gain[k0 + kk] : 1.f; LAS float* d = scr + kk * 33 + 4 * ch;
        d[0] = v[i][0] * gm; d[1] = v[i][1] * gm; d[2] = v[i][2] * gm; d[3] = v[i][3] * gm; }
    LDS_WAIT(); asm volatile("" ::: "memory");
    const int c = lane & 7;
#pragma unroll
    for (int j = 0; j < 4; ++j) { const int n = (lane >> 3) + 8 * j; const LAS float* s = scr + (8 * c) * 33 + n;
        u32x4 o; o.x = cvt_pk_bf16(s[0 * 33], s[1 * 33]); o.y = cvt_pk_bf16(s[2 * 33], s[3 * 33]); o.z = cvt_pk_bf16(s[4 * 33], s[5 * 33]); o.w = cvt_pk_bf16(s[6 * 33], s[7 * 33]);
        *(u32x4*)(WT + (size_t)(drow + n) * K + k0 + 8 * c) = o; }
    LDS_WAIT(); asm volatile("" ::: "memory");
}
__device__ __forceinline__ void cvt_matrix(const float* W, int K, int N, bf16* WT, int mode, int row_off, const float* gain, LAS float* scr, int gw, int ngw, int lane) {
    const int nblk = N / 32, items = (K / 64) * nblk;
    for (int it = gw; it < items; it += ngw) { const int kb = it / nblk, nb = it % nblk, n0 = 32 * nb;
        const int drow = mode ? ((n0 >> 7) * 256 + row_off + (n0 & 127)) : (row_off + n0);
        cvt_item(W, N, WT, K, 64 * kb, n0, drow, gain, scr, lane); }
}
__device__ __forceinline__ int rel_bucket(int rel) {
    const int n = rel < 0 ? -rel : rel; int v;
    if (n < 8) v = n; else if (n < 12) v = 8; else if (n < 16) v = 9; else if (n < 23) v = 10; else if (n < 32) v = 11; else if (n < 46) v = 12; else if (n < 64) v = 13; else if (n < 91) v = 14; else v = 15;
    return (rel > 0 ? 16 : 0) + v;
}

typedef const __attribute__((address_space(4))) Args* CArgsP;
__global__ void __launch_bounds__(512, 2) fwd_kernel(Args a) {
    extern __shared__ __attribute__((aligned(16))) unsigned char lds_raw[];
    LAS unsigned char* lds = (LAS unsigned char*)lds_raw;
    char* ldsg = (char*)lds_raw;
    volatile LAS unsigned* MISC = (volatile LAS unsigned*)(lds + MISC_OFF);
    const int tid = threadIdx.x, lane = tid & 63, wave = __builtin_amdgcn_readfirstlane(tid >> 6);
    const int G0 = gridDim.x; const int vcu0 = (G0 % 8 == 0) ? ((int)blockIdx.x % 8) * (G0 / 8) + (int)blockIdx.x / 8 : (int)blockIdx.x;
    unsigned* ctl = (unsigned*)(a.ws + WS_CTL);
    if (tid < 32) MISC[tid] = 0u;
    __syncthreads();
    XcdBarrier bar = xcd_barrier_post(ctl + CW_BAR, MISC + 8);
    const int lo = a.lo, hi = a.hi;
#ifndef SITE_MASK
#define SITE_MASK 0xFFFFFFFFu
#endif
#define SITE(k) (((SITE_MASK) >> (k)) & 1u)
#define PHASE_ON(id) (lo <= (id) && (id) < hi)
#define PHASE_SYNC(id) do { if ((id) != lo) xcd_barrier(bar); } while (0)
#define PH_PTRS CArgsP ap = (CArgsP)__builtin_amdgcn_kernarg_segment_ptr(); asm volatile("" : "+s"(ap)); unsigned char* ws = ap->ws; float* out = ap->out; float* SSQ = (float*)(ws + WS_SSQ); float* CONSTS = (float*)(ws + WS_CONST); \
    float* X = (float*)(ws + WS_X); bf16* XB = (bf16*)(ws + WS_XB); bf16* A0 = (bf16*)(ws + WS_A0); bf16* A2 = (bf16*)(ws + WS_A2); bf16* A3 = (bf16*)(ws + WS_A3); bf16* A4 = (bf16*)(ws + WS_A4); \
    float* ssq_mix = SSQ + (size_t)(2 * layer) * M * 8; float* ssq_ffn = SSQ + (size_t)(2 * layer + 1) * M * 8; float* ssq_next = SSQ + (size_t)(2 * layer + 2) * M * 8; \
    float* SSQS = (float*)(ws + WS_SSQS); float* sq_mix = SSQS + (size_t)(2 * layer) * 16384; float* sq_ffn = SSQS + (size_t)(2 * layer + 1) * 16384; float* sq_next = SSQS + (size_t)(2 * layer + 2) * 16384; (void)sq_mix; (void)sq_ffn; (void)sq_next; \
    (void)out; (void)CONSTS; (void)X; (void)XB; (void)A0; (void)A2; (void)A3; (void)A4; (void)ssq_mix; (void)ssq_ffn; (void)ssq_next; \
    int G = G0, vcu = vcu0, bx = (int)blockIdx.x; asm volatile("" : "+s"(G), "+s"(vcu), "+s"(bx)); (void)bx; \
    const int tid = opaque_tid(), lane = tid & 63, wave = __builtin_amdgcn_readfirstlane(tid >> 6), gw = vcu * 8 + wave, ngw = G * 8; (void)lane; (void)gw; (void)ngw;

    if (SITE(0) && PHASE_ON(0)) { const int layer = 0; PH_PTRS
        LAS float* scr = (LAS float*)(lds + wave * 16384);
#pragma unroll 1
        for (int j = 0; j < 2; ++j) { const float* gmix = ap->in[I_NMIX] + (size_t)(3 * j) * D; bf16* wt = (bf16*)(ws + WS_HG0 + j * HG_STRIDE); const size_t wo = (size_t)j * D * D;
            cvt_matrix(ap->in[I_HWQ] + wo, D, D, wt, 0, 0, gmix, scr, gw, ngw, lane);
            cvt_matrix(ap->in[I_HWF] + wo, D, D, wt, 0, 2048, gmix, scr, gw, ngw, lane);
            cvt_matrix(ap->in[I_HWI] + wo, D, D, wt, 0, 4096, gmix, scr, gw, ngw, lane);
            cvt_matrix(ap->in[I_HWG] + wo, D, D, wt, 0, 6144, gmix, scr, gw, ngw, lane);
            cvt_matrix(ap->in[I_HWO] + wo, D, D, wt + (size_t)NHG * D, 0, 0, nullptr, scr, gw, ngw, lane); }
        { const float* gmix = ap->in[I_NMIX] + (size_t)2 * D; bf16* wt = (bf16*)(ws + WS_QKV);
            cvt_matrix(ap->in[I_AWQ], D, D, wt, 0, 0, gmix, scr, gw, ngw, lane);
            cvt_matrix(ap->in[I_AWK], D, D, wt, 0, 2048, gmix, scr, gw, ngw, lane);
            cvt_matrix(ap->in[I_AWV], D, D, wt, 0, 4096, gmix, scr, gw, ngw, lane);
            cvt_matrix(ap->in[I_AWO], D, D, (bf16*)(ws + WS_WOA), 0, 0, nullptr, scr, gw, ngw, lane); }
#pragma unroll 1
        for (int g4 = 0; g4 < 4; ++g4) cvt_matrix(ap->in[I_PW] + (size_t)g4 * 512 * 512, 512, 512, (bf16*)(ws + WS_WP), 0, g4 * 512, nullptr, scr, gw, ngw, lane);
#pragma unroll 1
        for (int i = 0; i < 4; ++i) { const float* gf = ap->in[I_NFFN] + (size_t)i * D; bf16* w1 = (bf16*)(ws + WS_W1 + i * FFN_STRIDE); bf16* w2 = (bf16*)(ws + WS_W1 + i * FFN_STRIDE + W2_OFF);
            cvt_matrix(ap->in[I_FG] + (size_t)i * D * FF, D, FF, w1, 1, 0, gf, scr, gw, ngw, lane);
            cvt_matrix(ap->in[I_FU] + (size_t)i * D * FF, D, FF, w1, 1, 128, gf, scr, gw, ngw, lane);
            cvt_matrix(ap->in[I_FD] + (size_t)i * FF * D, FF, D, w2, 0, 0, nullptr, scr, gw, ngw, lane); }
        for (int m = gw; m < M; m += ngw) { const float* src = m < MP ? ap->in[I_XP] + (size_t)m * D : ap->in[I_XS] + (size_t)(m - MP) * D; float s = 0.f;
#pragma unroll
            for (int j = 0; j < 4; ++j) { const int c = j * 512 + lane * 8; f32x4 v0 = *(const f32x4*)(src + c), v1 = *(const f32x4*)(src + c + 4);
                const u32x4 w = pg8::pack8(v0, v1); *(u32x4*)(XB + (size_t)m * D + c) = w; pg8::unpack8(w, v0, v1);
                s += (v0[0] * v0[0] + v0[1] * v0[1]) + (v0[2] * v0[2] + v0[3] * v0[3]) + (v1[0] * v1[0] + v1[1] * v1[1]) + (v1[2] * v1[2] + v1[3] * v1[3]); }
            s = wave_sum(s); if (m < MP) { if (lane < 8) SSQ[(size_t)m * 8 + lane] = lane == 0 ? s : 0.f; } else SSQS[(size_t)(m - MP) * 64 + lane] = lane == 0 ? s : 0.f; }
        if (bx == 0) {
            for (int c = tid; c < D; c += 512) { const float l0 = ap->in[I_HLB][c], l1 = ap->in[I_HLB][D + c]; CONSTS[c] = 0.f; CONSTS[D + c] = 1.f / (1.f + __expf(l0 - l1)); }
            for (int e = tid; e < 2048; e += 512) { const int hh = e >> 8, idx = e & 255, rel = idx - 192;
                CONSTS[4608 + e] = (ap->in[I_REL][rel_bucket(rel) * 8 + hh] - ap->in[I_REL][15 * 8 + hh]) * (1.0f / ATT_SCALE); }
            if (wave == 0) { float s1 = 0.f, s2 = 0.f;
                for (int c = lane; c < 128; c += 64) { s1 += ap->in[I_LQ1][c] * ap->in[I_LK1][c]; s2 += ap->in[I_LQ2][c] * ap->in[I_LK2][c]; }
                s1 = wave_sum(s1); s2 = wave_sum(s2); if (lane == 0) CONSTS[4096] = __expf(s1) - __expf(s2) + LAMBDA_INIT; }
        }
    }

#pragma unroll 1
    for (int layer = 0; layer < 4; ++layer) {
        const int base = 1 + 10 * layer, mix = layer % 3;
        if (mix == 0) {
            const int j = layer / 3;
#define HG_PTRS PH_PTRS const bf16* whg = (const bf16*)(ws + WS_HG0 + j * HG_STRIDE); const bf16* who = whg + (size_t)NHG * D; \
            float* LOGF = (float*)(ws + WS_A1); bf16* SB = (bf16*)(ws + WS_SB); float* DT = (float*)(ws + WS_DT); (void)whg; (void)who; (void)LOGF; (void)SB; (void)DT;
            if (SITE(1) && PHASE_ON(base + 0)) { PHASE_SYNC(base + 0); HG_PTRS
                pg8::Gemm g{XB, whg, MP, NHG, D, D, D, 0}; pg8::StaticOrder S; S.init(MP, NHG, G, bx);
                pg8::EpiHgrn E{A0, LOGF, A2, A3, ssq_mix, CONSTS + j * D};
                pg8::gemm_phase<pg8::EpiHgrn, pg8::StaticOrder, true, true>(lds, g, S, E);
                sk::SkHgrn ES{A0, LOGF, sq_mix, CONSTS + j * D}; sk::skinny_phase<sk::SkHgrn, 2>(XB + (size_t)MP * D, D, 0, whg, D, D, NHG / 32, vcu, G, ES, (LAS float*)(lds + 131072), lds); }
            if (SITE(2) && PHASE_ON(base + 1)) { PHASE_SYNC(base + 1); HG_PTRS
                for (int it = vcu; it < 256; it += G) { const int h = it & 15, c = it >> 4;
                    hg::hgrn_state_item64(LOGF, A2, c * 1024, 16, h, SB + (size_t)(h * 16 + c) * 16384, DT + (size_t)(h * 16 + c) * 128, ldsg); } }
            if (SITE(3) && PHASE_ON(base + 2)) { PHASE_SYNC(base + 2); HG_PTRS
                for (int e = vcu * 512 + tid; e < 16 * 8192; e += G * 512) { const int h = e >> 13, k = (e & 8191) >> 6, v2 = (e & 63) * 2;
                    f32x2 s = {0.f, 0.f}; bf16* p = SB + ((size_t)h * 16 * 128 + k) * 128 + v2; const float* dp = DT + (size_t)h * 16 * 128 + k;
#pragma unroll 8
                    for (int c = 0; c < 16; ++c) { const unsigned bw = *(const unsigned*)(p + (size_t)c * 16384); const f32x2 bb = {__uint_as_float(bw << 16), __uint_as_float(bw & 0xffff0000u)}; const float d = dp[c * 128];
                        *(unsigned*)(p + (size_t)c * 16384) = cvt_pk_bf16(s[0], s[1]); s = s * d + bb; }
                    *(f32x2*)(out + OFF_HG_P + ((size_t)(j * 16 + h) * 128 + k) * 128 + v2) = s; } }
            if (SITE(4) && PHASE_ON(base + 3)) { PHASE_SYNC(base + 3); HG_PTRS
                const float* gain = ap->in[I_HGAIN] + j * 128;
                for (int it = vcu; it < 256; it += G) { const int h = it & 15, c = it >> 4;
                    hg::hgrn_item<true, true>(A0, LOGF, A2, A3, A4, c * 1024, 64, h, SB + (size_t)(h * 16 + c) * 16384, nullptr, nullptr, gain, ldsg); }
                for (int u = vcu; u < 256; u += G) { const int b = u >> 4, h = u & 15; const size_t so = ((size_t)(j * 16 + b) * 16 + h) * 16384;
                    hg::hgrn_item<true, false>(A0, LOGF, A2, A3, A4, MP + b * 16, 1, h, ap->in[I_SHG] + so, out + OFF_HG_S + so, nullptr, gain, ldsg); } }
            if (SITE(5) && PHASE_ON(base + 4)) { PHASE_SYNC(base + 4); HG_PTRS
                pg8::Gemm g{A4, who, MP, D, D, D, D, 0}; pg8::StaticOrder S; S.init(MP, D, G, bx);
                pg8::EpiResid E{X, XB, ssq_ffn, nullptr, (LAS float*)(lds + 131072)};
                pg8::gemm_phase<pg8::EpiResid, pg8::StaticOrder, true, true>(lds, g, S, E);
                sk::SkResid ES{X, XB, sq_ffn, nullptr}; sk::skinny_phase<sk::SkResid, 1>(A4 + (size_t)MP * D, D, 0, who, D, D, D / 32, vcu, G, ES, (LAS float*)(lds + 131072), lds); }
        } else if (mix == 1) {
            if (SITE(6) && PHASE_ON(base + 0)) { PHASE_SYNC(base + 0); PH_PTRS
                const float* gain = ap->in[I_NMIX] + (size_t)layer * D; const int c4 = tid * 4, grp = tid >> 7;
                for (int t = vcu; t < 256 + 16; t += G) {
                    int xrow0, nt, pos0, hm, npf; const float* hist = nullptr; float* np = nullptr;
                    if (t < 256) { xrow0 = 64 * t; nt = 64; pos0 = 64 * t; hm = t == 0 ? 1 : 0; npf = 49; if (t == 255) np = out + OFF_PL_P; }
                    else { const int b = t - 256; xrow0 = MP + 16 * b; nt = 16; pos0 = 4096; hm = 2; hist = ap->in[I_SPL] + (size_t)b * 15 * D; npf = 1; np = out + OFF_PL_S + (size_t)b * 15 * D; }
                    if (grp == 0) pool_tile<2>(XB, ssq_mix, sq_mix, gain, hist, hm, xrow0, nt, pos0, A0, np, npf, c4);
                    else if (grp == 1) pool_tile<4>(XB, ssq_mix, sq_mix, gain, hist, hm, xrow0, nt, pos0, A0, np, npf, c4);
                    else if (grp == 2) pool_tile<8>(XB, ssq_mix, sq_mix, gain, hist, hm, xrow0, nt, pos0, A0, np, npf, c4);
                    else pool_tile<16>(XB, ssq_mix, sq_mix, gain, hist, hm, xrow0, nt, pos0, A0, np, npf, c4); } }
            if (SITE(7) && PHASE_ON(base + 4)) { PHASE_SYNC(base + 4); PH_PTRS
                pg8::Gemm g{A0, (const bf16*)(ws + WS_WP), MP, D, 512, D, 512, 512}; pg8::StaticOrder S; S.init(MP, D, G, bx);
                pg8::EpiResid E{X, XB, ssq_ffn, ap->in[I_PSC], (LAS float*)(lds + 131072)};
                pg8::gemm_phase<pg8::EpiResid, pg8::StaticOrder, true, true>(lds, g, S, E);
                sk::SkResid ES{X, XB, sq_ffn, ap->in[I_PSC]}; sk::skinny_phase<sk::SkResid, 1>(A0 + (size_t)MP * D, D, 512, (const bf16*)(ws + WS_WP), 512, 512, D / 32, vcu, G, ES, (LAS float*)(lds + 131072), lds); }
        } else {
#define AT_PTRS PH_PTRS bf16* Kb = (bf16*)(ws + WS_A1); bf16* Oat = (bf16*)(ws + WS_A1 + 65 * MiB); float* PART = (float*)(ws + WS_PART); (void)Kb; (void)Oat; (void)PART;
            if (SITE(8) && PHASE_ON(base + 0)) { PHASE_SYNC(base + 0); AT_PTRS
                pg8::Gemm g{XB, (const bf16*)(ws + WS_QKV), MP, NQKV, D, D, D, 0}; pg8::StaticOrder S; S.init(MP, NQKV, G, bx);
                pg8::EpiQkv E{A0, Kb, A2, out, ssq_mix};
                pg8::gemm_phase<pg8::EpiQkv, pg8::StaticOrder, true, true>(lds, g, S, E);
                sk::SkQkv ES{A0, out, sq_mix}; sk::skinny_phase<sk::SkQkv, 2>(XB + (size_t)MP * D, D, 0, (const bf16*)(ws + WS_QKV), D, D, NQKV / 32, vcu, G, ES, (LAS float*)(lds + 131072), lds); }
            if (SITE(9) && PHASE_ON(base + 1)) { PHASE_SYNC(base + 1); AT_PTRS
                float* lut = (float*)(ldsg + 131072); float* scr = (float*)(ldsg + 131072 + 8192);
                for (int e = tid; e < 2048; e += 512) lut[e] = CONSTS[4608 + e];
                __syncthreads();
                if (SITE(15)) for (int u = vcu; u < 256; u += G) { const int b = u >> 4, h = (u >> 1) & 7, sp = u & 1;
                    att::attn_sample_unit(b, h, sp, A0, ap->in[I_CK], ap->in[I_CV], out + OFF_K_S, out + OFF_V_S, PART, lut + h * 256, ldsg, scr); __syncthreads(); }
            }
            if (SITE(9) && SITE(16) && PHASE_ON(base + 1)) { AT_PTRS
                float* lut = (float*)(ldsg + 131072); float* scr = (float*)(ldsg + 131072 + 8192);
                __syncthreads();
                for (int e = tid; e < 2048; e += 512) lut[e] = CONSTS[4608 + e];
                __syncthreads();
                for (int p = vcu; p < 1024; p += G) { const int hc = p >> 6, pr = p & 63, h = hc & 7, c = hc >> 3;
#pragma unroll 1
                    for (int which = 0; which < 2; ++which) { const int qb = which ? pr : 127 - pr;
                        att::attn_unit2(A0 + (size_t)qb * 128 * D + h * 256 + c * 128, Kb + h * 256 + c * 128, A2 + h * 256,
                                        A3 + (size_t)c * M * D + (size_t)qb * 128 * D + h * 256, 2 * qb + 2, 2 * qb + ((wave & 3) >> 1), 128 * qb + 32 * (wave & 3), lut + h * 256, ldsg, scr);
                        __syncthreads(); } } }
            if (SITE(10) && PHASE_ON(base + 2)) { PHASE_SYNC(base + 2); AT_PTRS
                const float lam = CONSTS[4096]; const f32x4 sg = *(const f32x4*)(ap->in[I_SUBG] + lane * 4);
                {
                    const f32x4 g0 = *(const f32x4*)(ap->in[I_SUBG] + (lane & 31) * 8), g1 = *(const f32x4*)(ap->in[I_SUBG] + (lane & 31) * 8 + 4);
                    for (int row = gw; row < MP; row += ngw) { const size_t off = (size_t)row * D + lane * 8; u32x4 wa[4], wb[4];
#pragma unroll
                        for (int q = 0; q < 4; ++q) { wa[q] = *(const u32x4*)(A3 + off + q * 512); wb[q] = *(const u32x4*)(A3 + (size_t)M * D + off + q * 512); }
#pragma unroll
                        for (int q = 0; q < 4; ++q) { f32x4 a0, a1, b0, b1; pg8::unpack8(wa[q], a0, a1); pg8::unpack8(wb[q], b0, b1);
                            a0 = a0 - b0 * lam; a1 = a1 - b1 * lam;
                            float ss = (a0[0] * a0[0] + a0[1] * a0[1]) + (a0[2] * a0[2] + a0[3] * a0[3]) + (a1[0] * a1[0] + a1[1] * a1[1]) + (a1[2] * a1[2] + a1[3] * a1[3]);
                            ss = row16_sum(ss); ss += __shfl_xor(ss, 16);
                            const float rs = __builtin_amdgcn_rsqf(ss * (1.f / 256.f) + EPS) * (1.f - LAMBDA_INIT);
                            *(u32x4*)(Oat + off + q * 512) = pg8::pack8(a0 * rs * g0, a1 * rs * g1); } } }
                for (int it = MP * 8 + gw; it < M * 8; it += ngw) { const int row = it >> 3, h = it & 7; f32x4 o;
                    if (row < MP) { const size_t off = (size_t)row * D + h * 256 + lane * 4; const u32x2 w0 = *(const u32x2*)(A3 + off), w1 = *(const u32x2*)(A3 + (size_t)M * D + off);
                        o[0] = __uint_as_float(w0.x << 16) - lam * __uint_as_float(w1.x << 16); o[1] = __uint_as_float(w0.x & 0xffff0000u) - lam * __uint_as_float(w1.x & 0xffff0000u);
                        o[2] = __uint_as_float(w0.y << 16) - lam * __uint_as_float(w1.y << 16); o[3] = __uint_as_float(w0.y & 0xffff0000u) - lam * __uint_as_float(w1.y & 0xffff0000u);
                    } else { const int b = (row - MP) >> 4, t = (row - MP) & 15, vhalf = lane >> 5, col = (lane & 31) * 4; f32x4 oc[2];
#pragma unroll
                        for (int c = 0; c < 2; ++c) { const float* p0 = PART + (size_t)((((b * 8 + h) * 2 + 0) * 4) + c * 2 + vhalf) * 2112; const float* p1 = p0 + 4 * 2112;
                            const float m0 = p0[t], m1 = p1[t], l0 = p0[16 + t], l1 = p1[16 + t], mm = fmaxf(m0, m1);
                            const float w0 = __builtin_amdgcn_exp2f((m0 - mm) * (ATT_SCALE * 1.4426950408889634f)), w1 = __builtin_amdgcn_exp2f((m1 - mm) * (ATT_SCALE * 1.4426950408889634f));
                            const f32x4 o0 = *(const f32x4*)(p0 + 64 + t * 128 + col), o1 = *(const f32x4*)(p1 + 64 + t * 128 + col);
                            oc[c] = (o0 * w0 + o1 * w1) * (1.0f / (l0 * w0 + l1 * w1)); }
                        o = oc[0] - oc[1] * lam; }
                    const float ss = wave_sum((o[0] * o[0] + o[1] * o[1]) + (o[2] * o[2] + o[3] * o[3]));
                    const float rs = __builtin_amdgcn_rsqf(ss * (1.f / 256.f) + EPS) * (1.f - LAMBDA_INIT);
                    o = o * rs * sg; u32x2 w; w.x = cvt_pk_bf16(o[0], o[1]); w.y = cvt_pk_bf16(o[2], o[3]);
                    *(u32x2*)(Oat + (size_t)row * D + h * 256 + lane * 4) = w; } }
            if (SITE(11) && PHASE_ON(base + 4)) { PHASE_SYNC(base + 4); AT_PTRS
                pg8::Gemm g{Oat, (const bf16*)(ws + WS_WOA), MP, D, D, D, D, 0}; pg8::StaticOrder S; S.init(MP, D, G, bx);
                pg8::EpiResid E{X, XB, ssq_ffn, nullptr, (LAS float*)(lds + 131072)};
                pg8::gemm_phase<pg8::EpiResid, pg8::StaticOrder, true, true>(lds, g, S, E);
                sk::SkResid ES{X, XB, sq_ffn, nullptr}; sk::skinny_phase<sk::SkResid, 1>(Oat + (size_t)MP * D, D, 0, (const bf16*)(ws + WS_WOA), D, D, D / 32, vcu, G, ES, (LAS float*)(lds + 131072), lds); }
        }
        if (SITE(12) && PHASE_ON(base + 5)) { PHASE_SYNC(base + 5); PH_PTRS
            const bf16* w1 = (const bf16*)(ws + WS_W1 + layer * FFN_STRIDE); pg8::Gemm g{XB, w1, MP, 2 * FF, D, D, D, 0}; pg8::StaticOrder S; S.init(MP, 2 * FF, G, bx);
            pg8::EpiFfn1 E{A0, ssq_ffn};
            pg8::gemm_phase<pg8::EpiFfn1, pg8::StaticOrder, true, true>(lds, g, S, E);
            sk::SkFfn1 ES{A0, sq_ffn}; sk::skinny_phase<sk::SkFfn1, 2>(XB + (size_t)MP * D, D, 0, w1, D, D, FF / 16, vcu, G, ES, (LAS float*)(lds + 131072), lds); }
        if (SITE(13) && PHASE_ON(base + 6)) { PHASE_SYNC(base + 6); PH_PTRS
            const bf16* w2 = (const bf16*)(ws + WS_W1 + layer * FFN_STRIDE + W2_OFF); pg8::Gemm g{A0, w2, MP, D, FF, FF, FF, 0}; pg8::StaticOrder S; S.init(MP, D, G, bx, 1);
            pg8::EpiResid E{X, XB, ssq_next, nullptr, (LAS float*)(lds + 131072)};
            pg8::gemm_phase<pg8::EpiResid, pg8::StaticOrder, true, true>(lds, g, S, E);
            sk::SkResid ES{X, XB, sq_next, nullptr}; sk::skinny_phase<sk::SkResid, 1>(A0 + (size_t)MP * FF, FF, 0, w2, FF, FF, D / 32, vcu, G, ES, (LAS float*)(lds + 131072), lds); }
    }
    if (SITE(14) && PHASE_ON(41)) { const int layer = 0;
        PHASE_SYNC(41); PH_PTRS
        const float* ssq = SSQ + (size_t)8 * M * 8; const float* gf = ap->in[I_NFIN];
        for (int m = gw; m < M; m += ngw) { const float rs = row_scale_any(ssq, SSQS + (size_t)8 * 16384, m); float* dst = m < MP ? out + OFF_Y_P + (size_t)m * D : out + OFF_Y_S + (size_t)(m - MP) * D;
#pragma unroll
            for (int j = 0; j < 8; ++j) { const int c = j * 256 + lane * 4; *(f32x4*)(dst + c) = ldx4(XB + (size_t)m * D + c) * rs * *(const f32x4*)(gf + c); } } }
}

extern "C" void kernel_launch(void* const* d_in, const int* in_sizes, int n_in, void* d_out, int out_size, void* d_ws, size_t ws_size, hipStream_t stream) {
    static int grid = 0;
    if (grid == 0) {
        if (n_in != 31 || (size_t)out_size != OUT_END || ws_size < WS_END) { fprintf(stderr, "kernel_launch: unexpected shapes: n_in %d out %d ws %zu\n", n_in, out_size, ws_size); grid = -1; return; }
        int dev = 0, cus = 0, per_cu = 0;
        if (hipGetDevice(&dev) != hipSuccess || hipDeviceGetAttribute(&cus, hipDeviceAttributeMultiprocessorCount, dev) != hipSuccess) { grid = -1; return; }
        if (hipFuncSetAttribute((const void*)fwd_kernel, hipFuncAttributeMaxDynamicSharedMemorySize, LDS_BYTES) != hipSuccess) { fprintf(stderr, "kernel_launch: hipFuncSetAttribute failed\n"); grid = -1; return; }
        if (hipOccupancyMaxActiveBlocksPerMultiprocessor(&per_cu, (const void*)fwd_kernel, 512, LDS_BYTES) != hipSuccess || per_cu < 1) { fprintf(stderr, "kernel_launch: occupancy query says %d\n", per_cu); (void)hipGetLastError(); per_cu = 1; }
        grid = cus;
    }
    if (grid < 0) return;
    (void)hipMemsetAsync((char*)d_ws + WS_CTL, 0, CTL_ZERO_BYTES, stream);
    Args a{};
    for (int i = 0; i < 31; ++i) a.in[i] = (const float*)d_in[i];
    a.out = (float*)d_out; a.ws = (unsigned char*)d_ws;
#if MK_ONE_LAUNCH
    a.lo = 0; a.hi = PH_END;
    hipLaunchKernelGGL(fwd_kernel, dim3(grid), dim3(512), LDS_BYTES, stream, a);
#else
    static const int ids[] = {0, 1, 2, 3, 4, 5, 6, 7, 11, 15, 16, 17, 21, 22, 23, 25, 26, 27, 31, 32, 33, 34, 35, 36, 37, 41};
    for (int k = 0; k < (int)(sizeof(ids) / sizeof(ids[0])); ++k) { a.lo = ids[k]; a.hi = ids[k] + 1; hipLaunchKernelGGL(fwd_kernel, dim3(grid), dim3(512), LDS_BYTES, stream, a); }
#endif
    const hipError_t le = hipPeekAtLastError();
    if (le != hipSuccess) fprintf(stderr, "kernel_launch: launch failed: %s\n", hipGetErrorName(le));
}
```

```cpp
#include <hip/hip_runtime.h>
#include <cstdio>
#include <cstdint>

#ifndef MK_ONE_LAUNCH
#define MK_ONE_LAUNCH 1
#endif

#define LAS __attribute__((address_space(3)))
#define GAS __attribute__((address_space(1)))
typedef unsigned short bf16;
typedef short bf16x8 __attribute__((ext_vector_type(8)));
typedef short s16x4 __attribute__((ext_vector_type(4)));
typedef float f32x4 __attribute__((ext_vector_type(4)));
typedef float f32x2 __attribute__((ext_vector_type(2)));
typedef float f32x8 __attribute__((ext_vector_type(8)));
typedef float f32x16 __attribute__((ext_vector_type(16)));
typedef unsigned u32x4 __attribute__((ext_vector_type(4)));
typedef unsigned u32x2 __attribute__((ext_vector_type(2)));

constexpr int D = 2048, MP = 16384, MS = 256, M = MP + MS, FF = 5632, NHG = 8192, NQKV = 6144;
constexpr float EPS = 1e-6f;
constexpr float LAMBDA_INIT = 0.4707130183435842f;
constexpr float ATT_SCALE = 0.088388347648318440f;
constexpr size_t OFF_Y_P = 0, OFF_Y_S = 33554432, OFF_HG_P = 34078720, OFF_HG_S = 34603008, OFF_PL_P = 42991616, OFF_PL_S = 43022336,
                 OFF_K_P = 43513856, OFF_V_P = 77068288, OFF_K_S = 110622720, OFF_V_S = 111147008, OUT_END = 111671296;
constexpr size_t MiB = 1u << 20;
constexpr size_t WS_CTL = 0, CTL_ZERO_BYTES = 64 * 1024;
constexpr size_t WS_CONST = 2 * MiB;
constexpr size_t WS_HG0 = 4 * MiB, HG_STRIDE = 40 * MiB;
constexpr size_t WS_QKV = 84 * MiB, WS_WOA = 108 * MiB, WS_WP = 116 * MiB;
constexpr size_t WS_W1 = 118 * MiB, FFN_STRIDE = 66 * MiB, W2_OFF = 44 * MiB;
constexpr size_t WS_X = 384 * MiB;
constexpr size_t WS_XB = 514 * MiB;
constexpr size_t WS_A0 = 580 * MiB;
constexpr size_t WS_A1 = 645 * MiB;
constexpr size_t WS_A2 = 775 * MiB;
constexpr size_t WS_A3 = 840 * MiB;
constexpr size_t WS_A4 = 905 * MiB;
constexpr size_t WS_SB = 970 * MiB;
constexpr size_t WS_DT = 1034 * MiB;
constexpr size_t WS_PART = 1036 * MiB;
constexpr size_t WS_SSQ = 1048 * MiB;
constexpr size_t WS_SSQS = 1054 * MiB;
constexpr size_t WS_END = 1056 * MiB;
constexpr int CW_TMO = 0, CW_BAR = 4096;
constexpr int LDS_BYTES = 147456, MISC_OFF = 131072 + 8192 + 2048 + 320;

__device__ __forceinline__ unsigned cvt_pk_bf16(float lo, float hi) { unsigned r; asm volatile("v_cvt_pk_bf16_f32 %0, %1, %2" : "=v"(r) : "v"(lo), "v"(hi)); return r; }
__device__ __forceinline__ float bf2f(unsigned short b) { return __uint_as_float(((unsigned)b) << 16); }
typedef _Float16 f16x2 __attribute__((ext_vector_type(2)));
__device__ __forceinline__ unsigned pk_f16(float a, float b) { f16x2 v; v.x = (_Float16)a; v.y = (_Float16)b; return __builtin_bit_cast(unsigned, v); }
__device__ __forceinline__ float h2f(unsigned short u) { return (float)__builtin_bit_cast(_Float16, u); }
__device__ __forceinline__ float wave_sum(float v) {
#pragma unroll
    for (int o = 1; o < 64; o <<= 1) v += __shfl_xor(v, o);
    return v;
}
__device__ __forceinline__ int opaque_tid() { int t = threadIdx.x; asm volatile("" : "+v"(t)); return t; }
__device__ __forceinline__ float row16_sum(float v) {
    v += __builtin_bit_cast(float, __builtin_amdgcn_update_dpp(0, __builtin_bit_cast(int, v), 0x128, 0xf, 0xf, false));
    v += __builtin_bit_cast(float, __builtin_amdgcn_update_dpp(0, __builtin_bit_cast(int, v), 0x124, 0xf, 0xf, false));
    v += __builtin_bit_cast(float, __builtin_amdgcn_update_dpp(0, __builtin_bit_cast(int, v), 0x122, 0xf, 0xf, false));
    v += __builtin_bit_cast(float, __builtin_amdgcn_update_dpp(0, __builtin_bit_cast(int, v), 0x121, 0xf, 0xf, false));
    return v;
}
__device__ __forceinline__ float fast_exp(float x) { return __builtin_amdgcn_exp2f(x * 1.4426950408889634f); }
__device__ __forceinline__ float sigmoidf_(float x) { return __builtin_amdgcn_rcpf(1.0f + fast_exp(-x)); }
__device__ __forceinline__ void sigmoid8(const float (&x)[8], float (&sg)[8]) {
    float e[8];
#define SG8_PIN() asm volatile("" : "+v"(e[0]), "+v"(e[1]), "+v"(e[2]), "+v"(e[3]), "+v"(e[4]), "+v"(e[5]), "+v"(e[6]), "+v"(e[7]))
#pragma unroll
    for (int j = 0; j < 8; ++j) e[j] = x[j] * -1.4426950408889634f;
    SG8_PIN();
#pragma unroll
    for (int j = 0; j < 8; ++j) e[j] = __builtin_amdgcn_exp2f(e[j]);
    SG8_PIN();
#pragma unroll
    for (int j = 0; j < 8; ++j) e[j] = 1.0f + e[j];
    SG8_PIN();
#pragma unroll
    for (int j = 0; j < 8; ++j) e[j] = __builtin_amdgcn_rcpf(e[j]);
    SG8_PIN();
#pragma unroll
    for (int j = 0; j < 8; ++j) sg[j] = e[j];
#undef SG8_PIN
}
#define LDS_WAIT() asm volatile("s_waitcnt lgkmcnt(0)" ::: "memory")
#define VM_WAIT() asm volatile("s_waitcnt vmcnt(0)" ::: "memory")

namespace pg8 {
#define PG8_LAS __attribute__((address_space(3)))
typedef unsigned short bf16_t;
constexpr int BM = 256, BK = 64, HALF = 128, HTB = HALF * BK * 2, STAGE_BYTES = 8 * HTB, NXCD = 8, WGM = 4;
__host__ __device__ __forceinline__ int lds_byte(int r, int c) { const int st = (r >> 4) * 2 + (c >> 5), rr = r & 15, cc = c & 31, ob = rr * 64 + cc * 2; return st * 1024 + (ob ^ (((ob >> 9) & 1) << 5)); }
__host__ __device__ __forceinline__ void stage_rc(int b, int& R, int& C) { const int st = b / 1024, sb = b % 1024, swz = sb ^ (((sb >> 9) & 1) << 5); R = (st >> 1) * 16 + swz / 64; C = (st & 1) * 32 + (swz % 64) / 2; }
__host__ __device__ __forceinline__ int perm32(int rho) { const int n = rho >> 4, i = rho & 15; return 8 * (i >> 2) + 4 * n + (i & 3); }
struct Unit { int pm, pn; };
struct Gemm { const bf16_t* A; const bf16_t* Bt; int M, N, K, lda, ldb, a_koff; };
struct StaticOrder {
    int nM, nN, nwg, G, c, rev;
    __host__ __device__ void init(int M_, int N_, int G_, int c_, int rev_ = 0) { nM = M_ / BM; nN = N_ / BM; nwg = nM * nN; G = G_; c = c_; rev = rev_; }
    __host__ __device__ bool next(int i, Unit& u) const {
        const long L = (long)i * G + c; if (L >= nwg) return false;
        int wgid = (int)L; { const int q = nwg / NXCD, r = nwg % NXCD, xcd = wgid % NXCD, off = wgid / NXCD; wgid = (xcd < r ? xcd * (q + 1) : r * (q + 1) + (xcd - r) * q) + off; }
        const int nig = WGM * nN, gid = wgid / nig, fm = gid * WGM, gsz = (nM - fm) < WGM ? (nM - fm) : WGM;
        u.pm = fm + ((wgid % nig) % gsz); u.pn = (wgid % nig) / gsz; if (rev) u.pm = nM - 1 - u.pm; return true;
    }
    __device__ __forceinline__ void a_ready(const Unit&) const {}
    __device__ __forceinline__ void done(const Unit&) const {}
};

__device__ __forceinline__ float row_scale(const float* ssq, int row);
template <class Epi, class Sched, bool ALIGN_EPI = false, bool SP2 = false>
__device__ __forceinline__ void gemm_phase(PG8_LAS unsigned char* lds, const Gemm g, const Sched& S, const Epi& E) {
    const int tid = opaque_tid(), wid = __builtin_amdgcn_readfirstlane(tid >> 6), lane = tid & 63, wr = wid >> 2, wc = wid & 3, fr = lane & 15, fq = lane >> 4;
    const int K = g.K, nt = K / BK;
    unsigned voffA[2], voffB[2];
#pragma unroll
    for (int i = 0; i < 2; ++i) { int R, C; stage_rc(tid * 16 + i * 8192, R, C); const int Rb = Epi::PERM ? ((R & ~31) + perm32(R & 31)) : R;
        voffA[i] = (unsigned)(R * g.lda + C) * 2u; voffB[i] = (unsigned)(Rb * g.ldb + C) * 2u; }
    const size_t kstep = (size_t)(BK * 2);
    const size_t hstepA = (size_t)HALF * g.lda * 2, hstepB = (size_t)HALF * g.ldb * 2;
    const size_t tstepA = 2 * hstepA, tstepB = 2 * hstepB;
    const unsigned ldsw = (unsigned)wid * 1024u;
    const int aoff = lds_byte(wr * 64 + fr, fq * 8), boff = lds_byte(wc * 32 + fr, fq * 8);
#define PG8_SA(b, h) (((b) * 2 + (h)) * HTB)
#define PG8_SB(b, h) ((4 + (b) * 2 + (h)) * HTB)
#define PG8_STAGE(bufoff, gbase, voff) do { _Pragma("unroll") for (int _i = 0; _i < 2; ++_i) \
        __builtin_amdgcn_global_load_lds((const unsigned*)((const char*)(gbase) + (voff)[_i]), (PG8_LAS unsigned*)(lds + (bufoff) + ldsw + _i * 8192), 16, 0, 0); } while (0)
#define PG8_LDA(dst, b, h) do { _Pragma("unroll") for (int m = 0; m < 4; ++m) _Pragma("unroll") for (int k = 0; k < 2; ++k) dst[m][k] = *(const PG8_LAS bf16x8*)(lds + PG8_SA(b, h) + aoff + m * 2048 + k * 1024); } while (0)
#define PG8_LDB(dst, b, h) do { _Pragma("unroll") for (int n = 0; n < 2; ++n) _Pragma("unroll") for (int k = 0; k < 2; ++k) dst[n][k] = *(const PG8_LAS bf16x8*)(lds + PG8_SB(b, h) + boff + n * 2048 + k * 1024); } while (0)
#define PG8_MMA(ai, bj, At, Bt) do { __builtin_amdgcn_s_setprio(1); _Pragma("unroll") for (int m = 0; m < 4; ++m) _Pragma("unroll") for (int n = 0; n < 2; ++n) _Pragma("unroll") for (int k = 0; k < 2; ++k) \
        acc[ai][bj][m][n] = __builtin_amdgcn_mfma_f32_16x16x32_bf16(Bt[n][k], At[m][k], acc[ai][bj][m][n], 0, 0, 0); __builtin_amdgcn_s_setprio(0); } while (0)
#define PG8_WAIT_V(n) asm volatile("s_waitcnt vmcnt(" #n ")" ::: "memory")
#define PG8_WAIT_L(n) asm volatile("s_waitcnt lgkmcnt(" #n ")" ::: "memory")
#define PG8_BAR __builtin_amdgcn_s_barrier()
#define PG8_SCHED __builtin_amdgcn_sched_barrier(0)
#define PG8_UA(u) ((const char*)g.A + (size_t)(u).pm * tstepA + (size_t)((u).pn >> 1) * (size_t)g.a_koff * 2)
#define PG8_UB(u) ((const char*)g.Bt + (size_t)(u).pn * tstepB)
    Unit cur, nxt; int ui = 0;
    if (!S.next(0, cur)) return;
    f32x4 acc[2][2][4][2];
#pragma unroll
    for (int a = 0; a < 2; ++a)
#pragma unroll
        for (int b = 0; b < 2; ++b)
#pragma unroll
            for (int m = 0; m < 4; ++m)
#pragma unroll
                for (int n = 0; n < 2; ++n) acc[a][b][m][n] = (f32x4){0.f, 0.f, 0.f, 0.f};
    bf16x8 At[4][2], B0[2][2], B1[2][2];
    const char* cA = PG8_UA(cur); const char* cB = PG8_UB(cur);
    S.a_ready(cur);
    float rsv[2][4];
#define PG8_RS(u_) do { if constexpr (Epi::NEEDS_RS) { _Pragma("unroll") for (int ai_ = 0; ai_ < 2; ++ai_) _Pragma("unroll") for (int m_ = 0; m_ < 4; ++m_) rsv[ai_][m_] = row_scale(E.ssq, (u_).pm * BM + wr * 64 + fr + ai_ * HALF + m_ * 16); } } while (0)
    PG8_RS(cur);
    if constexpr (SP2) {
        PG8_STAGE(PG8_SB(0, 0), cB, voffB); PG8_STAGE(PG8_SB(0, 1), cB + hstepB, voffB); PG8_STAGE(PG8_SA(0, 0), cA, voffA); PG8_STAGE(PG8_SA(0, 1), cA + hstepA, voffA);
        if (wr == 1) PG8_BAR;
        PG8_WAIT_V(2); PG8_BAR;
        PG8_STAGE(PG8_SB(1, 0), cB + kstep, voffB); PG8_STAGE(PG8_SA(1, 0), cA + kstep, voffA); PG8_STAGE(PG8_SB(1, 1), cB + hstepB + kstep, voffB);
        PG8_WAIT_V(6); PG8_BAR;
    } else {
        PG8_STAGE(PG8_SB(0, 0), cB, voffB); PG8_STAGE(PG8_SA(0, 0), cA, voffA); PG8_STAGE(PG8_SB(0, 1), cB + hstepB, voffB); PG8_STAGE(PG8_SA(0, 1), cA + hstepA, voffA);
        if (wr == 1) PG8_BAR;
        PG8_WAIT_V(4); PG8_BAR;
        PG8_STAGE(PG8_SB(1, 0), cB + kstep, voffB); PG8_STAGE(PG8_SA(1, 0), cA + kstep, voffA); PG8_STAGE(PG8_SB(1, 1), cB + hstepB + kstep, voffB);
        PG8_WAIT_V(6); PG8_BAR;
    }
    for (;;) {
        const bool has_next = S.next(ui + 1, nxt);
        const char* nA = has_next ? PG8_UA(nxt) : cA; const char* nB = has_next ? PG8_UB(nxt) : cB;
        for (int t = 0; t < nt; t += 2) {
            const bool last = (t == nt - 2);
            const char* a1 = cA + (size_t)(t + 1) * kstep;
            const char* a2 = last ? nA : cA + (size_t)(t + 2) * kstep; const char* b2 = last ? nB : cB + (size_t)(t + 2) * kstep;
            const char* a3 = a2 + kstep; const char* b3 = b2 + kstep;
            if (last && has_next) S.a_ready(nxt);
            if constexpr (SP2) {
            PG8_LDB(B0, 0, 0); PG8_LDB(B1, 0, 1); PG8_SCHED; PG8_LDA(At, 0, 0); PG8_STAGE(PG8_SA(1, 1), a1 + hstepA, voffA);
            PG8_WAIT_V(8); PG8_WAIT_L(0); PG8_BAR; PG8_MMA(0, 0, At, B0); PG8_MMA(0, 1, At, B1); PG8_BAR; PG8_SCHED;
            PG8_LDA(At, 0, 1); PG8_STAGE(PG8_SB(0, 0), b2, voffB); PG8_STAGE(PG8_SB(0, 1), b2 + hstepB, voffB); PG8_STAGE(PG8_SA(0, 0), a2, voffA);
            PG8_WAIT_V(8); PG8_WAIT_L(0); PG8_BAR; PG8_MMA(1, 0, At, B0); PG8_MMA(1, 1, At, B1); PG8_BAR; PG8_SCHED;
            PG8_LDB(B0, 1, 0); PG8_LDB(B1, 1, 1); PG8_SCHED; PG8_LDA(At, 1, 0); PG8_STAGE(PG8_SA(0, 1), a2 + hstepA, voffA);
            PG8_WAIT_V(8); PG8_WAIT_L(0); PG8_BAR; PG8_MMA(0, 0, At, B0); PG8_MMA(0, 1, At, B1); PG8_BAR; PG8_SCHED;
            PG8_LDA(At, 1, 1); PG8_STAGE(PG8_SB(1, 0), b3, voffB); PG8_STAGE(PG8_SB(1, 1), b3 + hstepB, voffB); PG8_STAGE(PG8_SA(1, 0), a3, voffA);
            PG8_WAIT_V(8); PG8_WAIT_L(0); PG8_BAR; PG8_MMA(1, 0, At, B0); PG8_MMA(1, 1, At, B1); PG8_BAR; PG8_SCHED;
            } else {
            PG8_LDB(B0, 0, 0); PG8_SCHED; PG8_LDA(At, 0, 0); PG8_STAGE(PG8_SA(1, 1), a1 + hstepA, voffA);
            PG8_WAIT_L(8); PG8_BAR; PG8_WAIT_L(0); PG8_MMA(0, 0, At, B0); PG8_BAR; PG8_SCHED;
            PG8_LDB(B1, 0, 1); PG8_STAGE(PG8_SB(0, 0), b2, voffB);
            PG8_BAR; PG8_WAIT_L(0); PG8_MMA(0, 1, At, B1); PG8_BAR;
            PG8_LDA(At, 0, 1); PG8_STAGE(PG8_SA(0, 0), a2, voffA);
            PG8_BAR; PG8_WAIT_L(0); PG8_MMA(1, 0, At, B0); PG8_BAR; PG8_SCHED;
            PG8_STAGE(PG8_SB(0, 1), b2 + hstepB, voffB);
            PG8_WAIT_V(6); PG8_BAR; PG8_MMA(1, 1, At, B1); PG8_BAR;
            PG8_LDB(B0, 1, 0); PG8_SCHED; PG8_LDA(At, 1, 0); PG8_STAGE(PG8_SA(0, 1), a2 + hstepA, voffA);
            PG8_WAIT_L(8); PG8_BAR; PG8_WAIT_L(0); PG8_MMA(0, 0, At, B0); PG8_BAR; PG8_SCHED;
            PG8_LDB(B1, 1, 1); PG8_STAGE(PG8_SB(1, 0), b3, voffB);
            PG8_BAR; PG8_WAIT_L(0); PG8_MMA(0, 1, At, B1); PG8_BAR;
            PG8_LDA(At, 1, 1); PG8_STAGE(PG8_SA(1, 0), a3, voffA);
            PG8_BAR; PG8_WAIT_L(0); PG8_MMA(1, 0, At, B0); PG8_BAR; PG8_SCHED;
            PG8_STAGE(PG8_SB(1, 1), b3 + hstepB, voffB);
            PG8_WAIT_V(6); PG8_BAR; PG8_MMA(1, 1, At, B1); PG8_BAR;
            }
        }
        if constexpr (ALIGN_EPI) { if (wr == 0) PG8_BAR; }
        E(acc, cur, wr, wc, fr, fq, rsv); S.done(cur);
        if (has_next) PG8_RS(nxt);
        if (!has_next) break;
#pragma unroll
        for (int a = 0; a < 2; ++a)
#pragma unroll
            for (int b = 0; b < 2; ++b)
#pragma unroll
                for (int m = 0; m < 4; ++m)
#pragma unroll
                    for (int n = 0; n < 2; ++n) acc[a][b][m][n] = (f32x4){0.f, 0.f, 0.f, 0.f};
        cur = nxt; cA = nA; cB = nB; ++ui;
        if constexpr (ALIGN_EPI) { if (wr == 1) PG8_BAR; }
    }
    PG8_WAIT_V(0);
    if constexpr (!ALIGN_EPI) { if (wr == 0) PG8_BAR; }
    PG8_BAR;
#undef PG8_SA
#undef PG8_SB
#undef PG8_STAGE
#undef PG8_LDA
#undef PG8_LDB
#undef PG8_MMA
#undef PG8_WAIT_V
#undef PG8_WAIT_L
#undef PG8_BAR
#undef PG8_SCHED
#undef PG8_UA
#undef PG8_UB
#undef PG8_RS
}

__device__ __forceinline__ float row_scale(const float* ssq, int row) { const f32x4 a = *(const f32x4*)(ssq + (size_t)row * 8), b = *(const f32x4*)(ssq + (size_t)row * 8 + 4);
    return __builtin_amdgcn_rsqf((((a[0] + a[1]) + (a[2] + a[3])) + ((b[0] + b[1]) + (b[2] + b[3]))) * (1.0f / 2048.0f) + 1e-6f); }
__device__ __forceinline__ void unpack8(u32x4 w, f32x4& a, f32x4& b) { a[0] = __uint_as_float(w.x << 16); a[1] = __uint_as_float(w.x & 0xffff0000u); a[2] = __uint_as_float(w.y << 16); a[3] = __uint_as_float(w.y & 0xffff0000u);
    b[0] = __uint_as_float(w.z << 16); b[1] = __uint_as_float(w.z & 0xffff0000u); b[2] = __uint_as_float(w.w << 16); b[3] = __uint_as_float(w.w & 0xffff0000u); }
__device__ __forceinline__ u32x4 pack8(f32x4 a, f32x4 b) { u32x4 w; w.x = cvt_pk_bf16(a[0], a[1]); w.y = cvt_pk_bf16(a[2], a[3]); w.z = cvt_pk_bf16(b[0], b[1]); w.w = cvt_pk_bf16(b[2], b[3]); return w; }

struct EpiResid {
    static constexpr bool PERM = true, NEEDS_RS = false;
    float* X; bf16_t* XB; float* ssq; const float* cs; PG8_LAS float* red;
    __device__ __forceinline__ void operator()(const f32x4 (&acc)[2][2][4][2], const Unit& u, int wr, int wc, int fr, int fq, const float (&rsv)[2][4]) const {
        const int row0 = u.pm * BM + wr * 64 + fr, col0 = u.pn * BM + wc * 32 + 8 * fq;
        f32x4 cv[2][2];
#pragma unroll
        for (int bj = 0; bj < 2; ++bj)
#pragma unroll
            for (int n = 0; n < 2; ++n) cv[bj][n] = cs ? *(const f32x4*)(cs + col0 + bj * HALF + 4 * n) : (f32x4){1.f, 1.f, 1.f, 1.f};
#pragma unroll
        for (int ai = 0; ai < 2; ++ai)
#pragma unroll
            for (int m = 0; m < 4; ++m) { const int row = row0 + ai * HALF + m * 16; float ss = 0.f;
#pragma unroll
                for (int bj = 0; bj < 2; ++bj) { bf16_t* xp = XB + (size_t)row * D + col0 + bj * HALF;
                    f32x4 a, b; unpack8(*(const u32x4*)xp, a, b);
                    a += acc[ai][bj][m][0] * cv[bj][0]; b += acc[ai][bj][m][1] * cv[bj][1];
                    const u32x4 w = pack8(a, b); *(u32x4*)xp = w; unpack8(w, a, b);
                    ss += (a[0] * a[0] + a[1] * a[1]) + (a[2] * a[2] + a[3] * a[3]) + (b[0] * b[0] + b[1] * b[1]) + (b[2] * b[2] + b[3] * b[3]); }
                ss += __shfl_xor(ss, 16); ss += __shfl_xor(ss, 32);
                if (fq == 0) red[(ai * HALF + wr * 64 + m * 16 + fr) * 4 + wc] = ss;
                asm volatile("" ::: "memory"); }
        asm volatile("s_waitcnt lgkmcnt(0)" ::: "memory"); __builtin_amdgcn_s_barrier(); asm volatile("" ::: "memory");
        const int t = wc * 64 + fq * 16 + fr;
        if (wr == 0) { const f32x4 v = *(const PG8_LAS f32x4*)(red + t * 4); ssq[(size_t)(u.pm * BM + t) * 8 + u.pn] = (v[0] + v[1]) + (v[2] + v[3]); }
    }
};
struct EpiFfn1 {
    static constexpr bool PERM = true, NEEDS_RS = true;
    bf16_t* H; const float* ssq;
    __device__ __forceinline__ void operator()(const f32x4 (&acc)[2][2][4][2], const Unit& u, int wr, int wc, int fr, int fq, const float (&rsv)[2][4]) const {
        const int row0 = u.pm * BM + wr * 64 + fr, col0 = u.pn * HALF + wc * 32 + 8 * fq;
#pragma unroll
        for (int ai = 0; ai < 2; ++ai)
#pragma unroll
            for (int m = 0; m < 4; ++m) { const int row = row0 + ai * HALF + m * 16; const float rs = rsv[ai][m];
                float g[8], sg[8]; f32x4 o[2];
#pragma unroll
                for (int j = 0; j < 8; ++j) g[j] = acc[ai][0][m][j >> 2][j & 3] * rs;
                sigmoid8(g, sg);
#pragma unroll
                for (int j = 0; j < 8; ++j) o[j >> 2][j & 3] = (g[j] * sg[j]) * (acc[ai][1][m][j >> 2][j & 3] * rs);
                *(u32x4*)(H + (size_t)row * FF + col0) = pack8(o[0], o[1]); }
    }
};
struct EpiHgrn {
    static constexpr bool PERM = true, NEEDS_RS = true;
    bf16_t* Q; float* LOGF; bf16_t* V; bf16_t* GS; const float* ssq; const float* lb;
    __device__ __forceinline__ void operator()(const f32x4 (&acc)[2][2][4][2], const Unit& u, int wr, int wc, int fr, int fq, const float (&rsv)[2][4]) const {
        const int seg = u.pn >> 3, row0 = u.pm * BM + wr * 64 + fr, col0 = (u.pn & 7) * BM + wc * 32 + 8 * fq;
        f32x4 lbv[2][2];
        if (seg == 1) {
#pragma unroll
            for (int bj = 0; bj < 2; ++bj)
#pragma unroll
                for (int n = 0; n < 2; ++n) lbv[bj][n] = *(const f32x4*)(lb + col0 + bj * HALF + 4 * n);
        }
#pragma unroll
        for (int ai = 0; ai < 2; ++ai)
#pragma unroll
            for (int m = 0; m < 4; ++m) { const int row = row0 + ai * HALF + m * 16; const float rs = rsv[ai][m];
#pragma unroll
                for (int bj = 0; bj < 2; ++bj) { f32x4 a = acc[ai][bj][m][0] * rs, b = acc[ai][bj][m][1] * rs; const size_t off = (size_t)row * D + col0 + bj * HALF;
                    if (seg == 1) { float z[8], sg[8];
#pragma unroll
                        for (int j = 0; j < 4; ++j) { z[j] = a[j]; z[4 + j] = b[j]; }
                        sigmoid8(z, sg);
#pragma unroll
                        for (int j = 0; j < 8; ++j) { const float l = lbv[bj][j >> 2][j & 3]; z[j] = fmaxf(l + (1.f - l) * sg[j], 1e-6f); }
#pragma unroll
                        for (int j = 0; j < 8; ++j) z[j] = __builtin_amdgcn_logf(z[j]);
#pragma unroll
                        for (int j = 0; j < 4; ++j) { a[j] = z[j]; b[j] = z[4 + j]; }
                        u32x4 lw_; lw_.x = pk_f16(a[0], a[1]); lw_.y = pk_f16(a[2], a[3]); lw_.z = pk_f16(b[0], b[1]); lw_.w = pk_f16(b[2], b[3]);
                        *(u32x4*)((unsigned short*)LOGF + off) = lw_;
                    } else {
                        if (seg == 3) { float z[8], sg[8];
#pragma unroll
                            for (int j = 0; j < 4; ++j) { z[j] = a[j]; z[4 + j] = b[j]; }
                            sigmoid8(z, sg);
#pragma unroll
                            for (int j = 0; j < 4; ++j) { a[j] = z[j] * sg[j]; b[j] = z[4 + j] * sg[4 + j]; } }
                        bf16_t* dst = (bf16_t*)((char*)Q + (size_t)(seg ? seg + 1 : 0) * (65 * MiB));
                        *(u32x4*)(dst + off) = pack8(a, b); } } }
    }
};
struct EpiQkv {
    static constexpr bool PERM = true, NEEDS_RS = true;
    bf16_t* Q; bf16_t* Kb; bf16_t* Vb; float* out; const float* ssq;
    __device__ __forceinline__ void operator()(const f32x4 (&acc)[2][2][4][2], const Unit& u, int wr, int wc, int fr, int fq, const float (&rsv)[2][4]) const {
        const int seg = u.pn >> 3, row0 = u.pm * BM + wr * 64 + fr, col0 = (u.pn & 7) * BM + wc * 32 + 8 * fq;
        bf16_t* dst = (bf16_t*)((char*)Q + (size_t)(seg + (seg >> 1)) * (65 * MiB));
        const bool smp = u.pm >= 64; const int frow0 = smp ? row0 - MP : row0;
        float* fo = out + (smp ? OFF_K_S : OFF_K_P) + (size_t)(seg ? seg - 1 : 0) * (smp ? (OFF_V_S - OFF_K_S) : (OFF_V_P - OFF_K_P));
#pragma unroll
        for (int ai = 0; ai < 2; ++ai)
#pragma unroll
            for (int m = 0; m < 4; ++m) { const int row = row0 + ai * HALF + m * 16; const float rs = rsv[ai][m];
#pragma unroll
                for (int bj = 0; bj < 2; ++bj) { const f32x4 a = acc[ai][bj][m][0] * rs, b = acc[ai][bj][m][1] * rs; const size_t off = (size_t)row * D + col0 + bj * HALF;
                    *(u32x4*)(dst + off) = pack8(a, b);
                    if (seg) { float* p = fo + (size_t)(frow0 + ai * HALF + m * 16) * D + col0 + bj * HALF; *(f32x4*)p = a; *(f32x4*)(p + 4) = b; } } }
    }
};
}

namespace sk {
__device__ __forceinline__ int crow(int r, int hi) { return (r & 3) + 8 * (r >> 2) + 4 * hi; }
__device__ __forceinline__ float row_scale_s(const float* ssqS, int row) { float t = 0.f;
#pragma unroll
    for (int i = 0; i < 16; ++i) { const f32x4 a = *(const f32x4*)(ssqS + (size_t)row * 64 + 4 * i); t += (a[0] + a[1]) + (a[2] + a[3]); }
    return __builtin_amdgcn_rsqf(t * (1.0f / 2048.0f) + 1e-6f); }
template <class Epi, int NC>
__device__ __forceinline__ void skinny_phase(const bf16* __restrict__ A, int lda, int a_goff, const bf16* __restrict__ Bt, int ldb, int K, int ncg, int vcu, int G, const Epi& E, LAS float* rs_tab, LAS unsigned char* lds) {
    const int tid = opaque_tid(), w = __builtin_amdgcn_readfirstlane(tid >> 6), lane = tid & 63, r32 = lane & 31, hi = lane >> 5, rblk = w & 1, kq = w >> 1;
    if (Epi::NEEDS_RS) { if (tid < 256) rs_tab[tid] = row_scale_s(E.ssqS, tid); }
    asm volatile("s_waitcnt lgkmcnt(0)" ::: "memory"); __builtin_amdgcn_s_barrier(); asm volatile("" ::: "memory");
    constexpr int BUF = 32768 + NC * 16384, NW2 = 2 * NC;
    const int srow = tid >> 5, sslot = tid & 31, nsc = K / 256;
    const int st0 = srow * 512 + ((sslot ^ (srow & 15)) << 4);
    const int rrow = 32 * rblk + r32;
    const int NU = 4 * (ncg / NC);
    bf16x8 ra[3][4], rw[3][NW2];
    const bf16* pa = A; const bf16* pw[NW2];
#pragma unroll
    for (int i = 0; i < NW2; ++i) pw[i] = Bt;
#define SK_PTRS(u_) do { const int cg_ = ((u_) >> 2) * NC, rb_ = (u_) & 3; \
        pa = A + (size_t)(64 * rb_ + srow) * lda + (size_t)(cg_ >> 4) * a_goff + sslot * 8; \
        _Pragma("unroll") for (int i = 0; i < NW2; ++i) pw[i] = Bt + (size_t)E.wrow(cg_ + (i >> 1), srow + 16 * (i & 1)) * ldb + sslot * 8; \
        asm volatile("" : "+v"(pa)); \
        _Pragma("unroll") for (int i = 0; i < NW2; ++i) asm volatile("" : "+v"(pw[i])); } while (0)
#define SK_LOAD(s_, c) do { _Pragma("unroll") for (int i = 0; i < 4; ++i) ra[s_][i] = *(const bf16x8*)(pa + (size_t)(16 * i) * lda + (c) * 256); \
        _Pragma("unroll") for (int i = 0; i < NW2; ++i) rw[s_][i] = *(const bf16x8*)(pw[i] + (c) * 256); } while (0)
#define SK_LOAD3() do { SK_LOAD(0, 0); if (1 < nsc) SK_LOAD(1, 1); if (2 < nsc) SK_LOAD(2, 2); } while (0)
#define SK_WRITE(s_, b) do { LAS unsigned char* bb = lds + (b) * BUF; _Pragma("unroll") for (int i = 0; i < 4; ++i) *(LAS bf16x8*)(bb + st0 + i * 8192) = ra[s_][i]; \
        _Pragma("unroll") for (int i = 0; i < NW2; ++i) *(LAS bf16x8*)(bb + 32768 + st0 + i * 8192) = rw[s_][i]; } while (0)
#define SK_STEP(j) do { const int c = c3 + (j); if (c < nsc) { \
            if (c + 1 < nsc) SK_WRITE(((j) + 1) % 3, (c + 1) & 1); \
            if (c + 3 < nsc) SK_LOAD((j), c + 3); \
            const LAS unsigned char* bb = lds + (c & 1) * BUF; \
            _Pragma("unroll") for (int i = 0; i < 4; ++i) { const int sl = 8 * kq + 2 * i + hi; \
                const bf16x8 af = *(const LAS bf16x8*)(bb + rrow * 512 + ((sl ^ (rrow & 15)) << 4)); \
                _Pragma("unroll") for (int g = 0; g < NC; ++g) { const bf16x8 wf = *(const LAS bf16x8*)(bb + 32768 + (32 * g + r32) * 512 + ((sl ^ (r32 & 15)) << 4)); \
                    acc[g] = __builtin_amdgcn_mfma_f32_32x32x16_bf16(wf, af, acc[g], 0, 0, 0); } } \
            asm volatile("s_waitcnt lgkmcnt(0)" ::: "memory"); __builtin_amdgcn_s_barrier(); asm volatile("" ::: "memory"); } } while (0)
    int u = vcu;
    if (u < NU) { SK_PTRS(u); SK_LOAD3(); }
#pragma unroll 1
    while (u < NU) {
        const int cg = (u >> 2) * NC, rb = u & 3;
        f32x16 acc[NC] = {};
        SK_WRITE(0, 0);
        asm volatile("s_waitcnt lgkmcnt(0)" ::: "memory"); __builtin_amdgcn_s_barrier(); asm volatile("" ::: "memory");
#pragma unroll 1
        for (int c3 = 0; c3 < nsc; c3 += 3) { SK_STEP(0); SK_STEP(1); SK_STEP(2); }
        const int un = u + G;
        if (un < NU) { SK_PTRS(un); SK_LOAD3(); }
        LAS float* pb = (LAS float*)lds + (w * NC) * 1024 + lane;
        asm volatile("" : "+v"(pb));
#pragma unroll
        for (int g = 0; g < NC; ++g)
#pragma unroll
            for (int r = 0; r < 16; ++r) pb[(g * 16 + r) * 64] = acc[g][r];
        asm volatile("s_waitcnt lgkmcnt(0)" ::: "memory"); __builtin_amdgcn_s_barrier(); asm volatile("" ::: "memory");
        if (kq == 0) {
            const int row = 64 * rb + rrow; const float rs = Epi::NEEDS_RS ? rs_tab[row] : 1.f;
#pragma unroll
            for (int g = 0; g < NC; ++g) {
#pragma unroll
                for (int r = 0; r < 16; ++r) { const int o_ = (g * 16 + r) * 64; acc[g][r] = ((pb[o_] + pb[o_ + 2 * NC * 1024]) + pb[o_ + 4 * NC * 1024]) + pb[o_ + 6 * NC * 1024]; }
                E(acc[g], cg + g, row, hi, rs); }
        }
        asm volatile("s_waitcnt lgkmcnt(0)" ::: "memory"); __builtin_amdgcn_s_barrier(); asm volatile("" ::: "memory");
        u = un;
    }
#undef SK_PTRS
#undef SK_LOAD
#undef SK_LOAD3
#undef SK_WRITE
#undef SK_STEP
}
__device__ __forceinline__ u32x2 pack4(float a, float b, float c, float d) { u32x2 w; w.x = cvt_pk_bf16(a, b); w.y = cvt_pk_bf16(c, d); return w; }
struct SkResid {
    static constexpr bool NEEDS_RS = false;
    float* X; bf16* XB; float* ssqS; const float* cs;
    __device__ __forceinline__ int wrow(int u, int m) const { return 32 * u + m; }
    __device__ __forceinline__ void operator()(const f32x16& acc, int u, int row, int hi, float) const {
        float ss = 0.f;
#pragma unroll
        for (int q = 0; q < 4; ++q) { const int c = 32 * u + 8 * q + 4 * hi; bf16* xp = XB + (size_t)(MP + row) * D + c;
            const u32x2 w0 = *(const u32x2*)xp; f32x4 xv = {__uint_as_float(w0.x << 16), __uint_as_float(w0.x & 0xffff0000u), __uint_as_float(w0.y << 16), __uint_as_float(w0.y & 0xffff0000u)};
            f32x4 av = {acc[4 * q], acc[4 * q + 1], acc[4 * q + 2], acc[4 * q + 3]};
            if (cs) av *= *(const f32x4*)(cs + c);
            xv += av; const u32x2 w1 = pack4(xv[0], xv[1], xv[2], xv[3]); *(u32x2*)xp = w1;
            xv = (f32x4){__uint_as_float(w1.x << 16), __uint_as_float(w1.x & 0xffff0000u), __uint_as_float(w1.y << 16), __uint_as_float(w1.y & 0xffff0000u)};
            ss += (xv[0] * xv[0] + xv[1] * xv[1]) + (xv[2] * xv[2] + xv[3] * xv[3]); }
        ss += __shfl_xor(ss, 32);
        if (hi == 0) ssqS[(size_t)row * 64 + u] = ss;
    }
};
struct SkFfn1 {
    static constexpr bool NEEDS_RS = true;
    bf16* H; const float* ssqS;
    __device__ __forceinline__ int wrow(int u, int m) const { const int j = 16 * u + (m & 15); return (j >> 7) * 256 + (j & 127) + (m >> 4) * 128; }
    __device__ __forceinline__ void operator()(const f32x16& acc, int u, int row, int hi, float rs) const {
#pragma unroll
        for (int q = 0; q < 2; ++q) { float o[4];
#pragma unroll
            for (int i = 0; i < 4; ++i) { const float gt = acc[4 * q + i] * rs, up = acc[4 * q + i + 8] * rs; o[i] = gt * sigmoidf_(gt) * up; }
            *(u32x2*)(H + (size_t)(MP + row) * FF + 16 * u + 8 * q + 4 * hi) = pack4(o[0], o[1], o[2], o[3]); }
    }
};
struct SkHgrn {
    static constexpr bool NEEDS_RS = true;
    bf16* Q; float* LOGF; const float* ssqS; const float* lb;
    __device__ __forceinline__ int wrow(int u, int m) const { return 32 * u + m; }
    __device__ __forceinline__ void operator()(const f32x16& acc, int u, int row, int hi, float rs) const {
        const int seg = u >> 6;
#pragma unroll
        for (int q = 0; q < 4; ++q) { const int c = 32 * (u & 63) + 8 * q + 4 * hi; const size_t off = (size_t)(MP + row) * D + c;
            f32x4 a = {acc[4 * q] * rs, acc[4 * q + 1] * rs, acc[4 * q + 2] * rs, acc[4 * q + 3] * rs};
            if (seg == 1) { const f32x4 l = *(const f32x4*)(lb + c);
#pragma unroll
                for (int j = 0; j < 4; ++j) a[j] = __builtin_amdgcn_logf(fmaxf(l[j] + (1.f - l[j]) * sigmoidf_(a[j]), 1e-6f));
                u32x2 lw_; lw_.x = pk_f16(a[0], a[1]); lw_.y = pk_f16(a[2], a[3]); *(u32x2*)((unsigned short*)LOGF + off) = lw_;
            } else {
                if (seg == 3) {
#pragma unroll
                    for (int j = 0; j < 4; ++j) a[j] = a[j] * sigmoidf_(a[j]); }
                bf16* dst = (bf16*)((char*)Q + (size_t)(seg ? seg + 1 : 0) * (65 * MiB));
                *(u32x2*)(dst + off) = pack4(a[0], a[1], a[2], a[3]); } }
    }
};
struct SkQkv {
    static constexpr bool NEEDS_RS = true;
    bf16* Q; float* out; const float* ssqS;
    __device__ __forceinline__ int wrow(int u, int m) const { return 32 * u + m; }
    __device__ __forceinline__ void operator()(const f32x16& acc, int u, int row, int hi, float rs) const {
        const int seg = u >> 6;
        bf16* dst = (bf16*)((char*)Q + (size_t)(seg + (seg >> 1)) * (65 * MiB));
        float* fo = out + OFF_K_S + (size_t)(seg ? seg - 1 : 0) * (OFF_V_S - OFF_K_S);
#pragma unroll
        for (int q = 0; q < 4; ++q) { const int c = 32 * (u & 63) + 8 * q + 4 * hi;
            const f32x4 a = {acc[4 * q] * rs, acc[4 * q + 1] * rs, acc[4 * q + 2] * rs, acc[4 * q + 3] * rs};
            *(u32x2*)(dst + (size_t)(MP + row) * D + c) = pack4(a[0], a[1], a[2], a[3]);
            if (seg) *(f32x4*)(fo + (size_t)row * D + c) = a; }
    }
};
}

namespace att {
constexpr int KVBLK = 64, QBLK = 32, NW = 8, LD = 2048;
constexpr float SCALE = ATT_SCALE, THR = 8.f;
constexpr int SHM_V = KVBLK * 128 * 2, SHM_K = KVBLK * 128 * 2;
#define KSWZ(row, colB) ((row) * 256 + ((colB) ^ (((row) & 7) << 4)))
#define SBAR() __builtin_amdgcn_sched_barrier(0)
__device__ __forceinline__ int crow(int r, int hi) { return (r & 3) + 8 * (r >> 2) + 4 * hi; }
__device__ __forceinline__ void partialSM(f32x16& p0, f32x16& p1, float& m_reg, float& mn, float& alpha) {
  constexpr float C = SCALE * 1.4426950408889634f;
  float pmax = fmaxf(p0[0], p1[0]);
#pragma unroll
  for (int r = 1; r < 16; ++r) pmax = __builtin_fmaxf(__builtin_fmaxf(pmax, p0[r]), p1[r]);
  { auto rr = __builtin_amdgcn_permlane32_swap(__float_as_uint(pmax), __float_as_uint(pmax), false, false);
    pmax = fmaxf(__uint_as_float(rr[0]), __uint_as_float(rr[1])); }
  if (__builtin_expect(__all(pmax - m_reg <= THR / SCALE), 1)) { mn = m_reg; alpha = 1.f; }
  else { mn = fmaxf(m_reg, pmax); alpha = __builtin_amdgcn_exp2f((m_reg - mn) * C); m_reg = mn; }
  float mnC = -mn * C;
#pragma unroll
  for (int r = 0; r < 16; ++r) p0[r] = fmaf(p0[r], C, mnC);
#pragma unroll
  for (int r = 0; r < 16; ++r) p1[r] = fmaf(p1[r], C, mnC);
#pragma unroll
  for (int r = 0; r < 16; ++r) p0[r] = __builtin_amdgcn_exp2f(p0[r]);
}
__device__ __forceinline__ void finishSM(f32x16& p0, f32x16& p1, float alpha, float& l_reg, bf16x8& pa0, bf16x8& pa1, bf16x8& pa2, bf16x8& pa3) {
#pragma unroll
  for (int r = 0; r < 16; ++r) p1[r] = __builtin_amdgcn_exp2f(p1[r]);
  float ps = 0;
#pragma unroll
  for (int r = 0; r < 16; ++r) ps += p0[r];
#pragma unroll
  for (int r = 0; r < 16; ++r) ps += p1[r];
  { auto rr = __builtin_amdgcn_permlane32_swap(__float_as_uint(ps), __float_as_uint(ps), false, false);
    ps = __uint_as_float(rr[0]) + __uint_as_float(rr[1]); }
  l_reg = l_reg * alpha + ps;
#define PK4(P, BASE, OUT) do { unsigned a0 = cvt_pk_bf16(P[BASE + 0], P[BASE + 1]), a1 = cvt_pk_bf16(P[BASE + 2], P[BASE + 3]);   \
    unsigned b0 = cvt_pk_bf16(P[BASE + 4], P[BASE + 5]), b1 = cvt_pk_bf16(P[BASE + 6], P[BASE + 7]);                              \
    auto r0 = __builtin_amdgcn_permlane32_swap(a0, b0, false, false); auto r1 = __builtin_amdgcn_permlane32_swap(a1, b1, false, false); \
    u32x4 w = {r0[0], r1[0], r0[1], r1[1]}; OUT = *reinterpret_cast<bf16x8*>(&w); } while (0)
  PK4(p0, 0, pa0); PK4(p0, 8, pa1); PK4(p1, 0, pa2); PK4(p1, 8, pa3);
#undef PK4
}
__device__ __forceinline__ void qkt(f32x16& p0, f32x16& p1, const char* Ks, const bf16x8* qr, int r32, int hi) {
  p0 = f32x16{}; p1 = f32x16{};
#pragma unroll
  for (int d0 = 0; d0 < 8; ++d0) { int cb = (d0 * 16 + hi * 8) * 2;
    bf16x8 b0 = *reinterpret_cast<const bf16x8*>(Ks + KSWZ(r32, cb));
    bf16x8 b1 = *reinterpret_cast<const bf16x8*>(Ks + KSWZ(32 + r32, cb));
    p0 = __builtin_amdgcn_mfma_f32_32x32x16_bf16(b0, qr[d0], p0, 0, 0, 0);
    p1 = __builtin_amdgcn_mfma_f32_32x32x16_bf16(b1, qr[d0], p1, 0, 0, 0); }
}
__device__ __forceinline__ int v_st(int k, int c) { const int kk = (k & ~0xC) | ((k & 4) << 1) | ((k & 8) >> 1); return ((kk >> 3) * 4 + (c >> 5)) * 512 + ((kk & 7) * 32 + (c & 31)) * 2; }
__device__ __forceinline__ int v_rd_base(int lane) { return ((lane & 3) << 3) | (((lane >> 2) & 3) << 6) | (((lane >> 4) & 1) << 5) | (((lane >> 5) & 1) << 8); }
constexpr int v_rd_off(int d0, int ks, int half) { return d0 * 512 + ks * 4096 + half * 2048; }
template <int OFF> __device__ __forceinline__ s16x4 tr_read(int vb) {
  s16x4 r; asm volatile("ds_read_b64_tr_b16 %0, %1 offset:%2" : "=&v"(r) : "v"(vb), "i"(OFF) : "memory"); return r;
}
template <int D0> __device__ __forceinline__ void pv_one(f32x16& od, int vb, bf16x8 pa0, bf16x8 pa1, bf16x8 pa2, bf16x8 pa3) {
  const s16x4 l0 = tr_read<v_rd_off(D0, 0, 0)>(vb), h0 = tr_read<v_rd_off(D0, 0, 1)>(vb), l1 = tr_read<v_rd_off(D0, 1, 0)>(vb), h1 = tr_read<v_rd_off(D0, 1, 1)>(vb);
  const s16x4 l2 = tr_read<v_rd_off(D0, 2, 0)>(vb), h2 = tr_read<v_rd_off(D0, 2, 1)>(vb), l3 = tr_read<v_rd_off(D0, 3, 0)>(vb), h3 = tr_read<v_rd_off(D0, 3, 1)>(vb);
  asm volatile("s_waitcnt lgkmcnt(0)" ::: "memory"); SBAR();
#define PK(L, H) (bf16x8){L[0], L[1], L[2], L[3], H[0], H[1], H[2], H[3]}
  od = __builtin_amdgcn_mfma_f32_32x32x16_bf16(pa0, PK(l0, h0), od, 0, 0, 0);
  od = __builtin_amdgcn_mfma_f32_32x32x16_bf16(pa1, PK(l1, h1), od, 0, 0, 0);
  od = __builtin_amdgcn_mfma_f32_32x32x16_bf16(pa2, PK(l2, h2), od, 0, 0, 0);
  od = __builtin_amdgcn_mfma_f32_32x32x16_bf16(pa3, PK(l3, h3), od, 0, 0, 0);
#undef PK
}
template <int D0> __device__ __forceinline__ void pv_two(f32x16& oa, f32x16& ob, int vb, bf16x8 pa0, bf16x8 pa1, bf16x8 pa2, bf16x8 pa3, bf16x8 pb0, bf16x8 pb1, bf16x8 pb2, bf16x8 pb3) {
  const s16x4 l0 = tr_read<v_rd_off(D0, 0, 0)>(vb), h0 = tr_read<v_rd_off(D0, 0, 1)>(vb), l1 = tr_read<v_rd_off(D0, 1, 0)>(vb), h1 = tr_read<v_rd_off(D0, 1, 1)>(vb);
  const s16x4 l2 = tr_read<v_rd_off(D0, 2, 0)>(vb), h2 = tr_read<v_rd_off(D0, 2, 1)>(vb), l3 = tr_read<v_rd_off(D0, 3, 0)>(vb), h3 = tr_read<v_rd_off(D0, 3, 1)>(vb);
  asm volatile("s_waitcnt lgkmcnt(0)" ::: "memory"); SBAR();
#define PK2(L, H) (bf16x8){L[0], L[1], L[2], L[3], H[0], H[1], H[2], H[3]}
  oa = __builtin_amdgcn_mfma_f32_32x32x16_bf16(pa0, PK2(l0, h0), oa, 0, 0, 0); ob = __builtin_amdgcn_mfma_f32_32x32x16_bf16(pb0, PK2(l0, h0), ob, 0, 0, 0);
  oa = __builtin_amdgcn_mfma_f32_32x32x16_bf16(pa1, PK2(l1, h1), oa, 0, 0, 0); ob = __builtin_amdgcn_mfma_f32_32x32x16_bf16(pb1, PK2(l1, h1), ob, 0, 0, 0);
  oa = __builtin_amdgcn_mfma_f32_32x32x16_bf16(pa2, PK2(l2, h2), oa, 0, 0, 0); ob = __builtin_amdgcn_mfma_f32_32x32x16_bf16(pb2, PK2(l2, h2), ob, 0, 0, 0);
  oa = __builtin_amdgcn_mfma_f32_32x32x16_bf16(pa3, PK2(l3, h3), oa, 0, 0, 0); ob = __builtin_amdgcn_mfma_f32_32x32x16_bf16(pb3, PK2(l3, h3), ob, 0, 0, 0);
#undef PK2
}
__device__ __forceinline__ void pv_d0(f32x16* o, int vb, bf16x8 pa0, bf16x8 pa1, bf16x8 pa2, bf16x8 pa3) {
  pv_one<0>(o[0], vb, pa0, pa1, pa2, pa3); pv_one<1>(o[1], vb, pa0, pa1, pa2, pa3); pv_one<2>(o[2], vb, pa0, pa1, pa2, pa3); pv_one<3>(o[3], vb, pa0, pa1, pa2, pa3);
}
__device__ __forceinline__ void fix_prompt(f32x16& p0, f32x16& p1, int jt, int lim, int qrow0, int r32, int hi, const float* lut) {
  if (jt > lim) {
#pragma unroll
    for (int r = 0; r < 16; ++r) { p0[r] = -1e30f; p1[r] = -1e30f; }
  } else if (64 * jt >= qrow0 - 153) {
    const float* lp = lut + (64 * jt - (qrow0 + r32) + 192);
#pragma unroll
    for (int r = 0; r < 16; ++r) { p0[r] += lp[crow(r, hi)]; p1[r] += lp[32 + crow(r, hi)]; }
  }
}

#define RESC(a) do { if (__any((a) < 1.f)) { if (hi == 0) al_l[r32] = (a); asm volatile("s_waitcnt lgkmcnt(0)" ::: "memory"); \
    _Pragma("unroll") for (int d = 0; d < 4; ++d) _Pragma("unroll") for (int r = 0; r < 16; ++r) o[d][r] *= al_l[crow(r, hi)]; } } while (0)
__device__ __forceinline__ void attn_unit2(const bf16* __restrict__ Qb, const bf16* __restrict__ Kh, const bf16* __restrict__ Vh, bf16* __restrict__ Ob,
                                           int NT, int lim, int qrow0, const float* lut, char* lds, float* scr) {
  const int tid = opaque_tid(), wid = __builtin_amdgcn_readfirstlane(tid >> 6), lane = tid & 63, r32 = lane & 31, hi = lane >> 5, a = wid & 3;
  const bool isA = wid < 4;
  char* K_lds = lds; char* V_lds = lds + 32768; char* P_lds = lds + 98304 + a * 4096;
  float* alpha_l = scr + a * 32; float* l_l = scr + 256 + a * 32;
  unsigned kgo[4], vgo[4];
#pragma unroll
  for (int i = 0; i < 4; ++i) { const int pq = 4 * a + i, g = 64 * pq + lane;
    { const int row = g >> 4, cc = (g & 15) ^ (row & 7); kgo[i] = (unsigned)(row * LD + cc * 8) * 2u; }
    { const int sub = g >> 5, kk = (sub >> 2) * 8 + ((g >> 2) & 7), k = (kk & ~0xC) | ((kk & 4) << 1) | ((kk & 8) >> 1), col = (sub & 3) * 32 + (g & 3) * 8; vgo[i] = (unsigned)(k * LD + col) * 2u; } }
  const int vrb = (int)(uintptr_t)V_lds + v_rd_base(lane);
  LAS char* K_las = (LAS char*)K_lds; LAS char* V_las = (LAS char*)V_lds;
#define DMA_K(j_, b_) do { const char* kb_ = (const char*)Kh + (size_t)(j_) * (64 * LD * 2); _Pragma("unroll") for (int i = 0; i < 4; ++i) \
    __builtin_amdgcn_global_load_lds((const unsigned*)(kb_ + kgo[i]), (LAS unsigned*)(K_las + (b_) * 16384 + (4 * a + i) * 1024), 16, 0, 0); } while (0)
#define DMA_V(j_, b_) do { const char* vb_ = (const char*)Vh + (size_t)(j_) * (64 * LD * 2); _Pragma("unroll") for (int hf = 0; hf < 2; ++hf) _Pragma("unroll") for (int i = 0; i < 4; ++i) \
    __builtin_amdgcn_global_load_lds((const unsigned*)(vb_ + hf * 256 + vgo[i]), (LAS unsigned*)(V_las + (b_) * 32768 + hf * 16384 + (4 * a + i) * 1024), 16, 0, 0); } while (0)
  if (!isA) DMA_K(0, 0);
  asm volatile("s_waitcnt vmcnt(0)" ::: "memory");
  __syncthreads();
  if (isA) {
    float m_reg = -1e30f, l_reg = 0; bf16x8 qr[8];
    const bf16* Qw = Qb + (long)(a * QBLK + r32) * LD + hi * 8;
#pragma unroll
    for (int d0 = 0; d0 < 8; ++d0) qr[d0] = *reinterpret_cast<const bf16x8*>(Qw + d0 * 16);
    for (int j = 0; j <= NT; ++j) {
      if (j < NT) {
        f32x16 p0, p1; float mn, al; bf16x8 pa0, pa1, pa2, pa3;
        __builtin_amdgcn_s_setprio(3);
        qkt(p0, p1, K_lds + (j & 1) * 16384, qr, r32, hi);
        fix_prompt(p0, p1, j, lim, qrow0, r32, hi, lut);
        partialSM(p0, p1, m_reg, mn, al);
        finishSM(p0, p1, al, l_reg, pa0, pa1, pa2, pa3);
        __builtin_amdgcn_s_setprio(0);
        char* ps = P_lds + (j & 1) * 16384 + lane * 16;
        *(bf16x8*)(ps) = pa0; *(bf16x8*)(ps + 1024) = pa1; *(bf16x8*)(ps + 2048) = pa2; *(bf16x8*)(ps + 3072) = pa3;
        if (hi == 0) alpha_l[(j & 1) * 128 + r32] = al;
      }
      __syncthreads();
    }
    if (hi == 0) l_l[r32] = l_reg;
    __syncthreads();
  } else {
    const int rp = a >> 1, ch = a & 1;
    const char* P0 = lds + 98304 + (2 * rp) * 4096; const float* al0 = scr + (2 * rp) * 32; const float* ll0 = scr + 256 + (2 * rp) * 32;
    f32x16 o[2][4] = {};
    for (int j = 0; j <= NT; ++j) {
      const float* al = al0 + ((j + 1) & 1) * 128;
      const char* ps = P0 + ((j + 1) & 1) * 16384 + lane * 16;
      const bf16x8 pa0 = *(const bf16x8*)(ps), pa1 = *(const bf16x8*)(ps + 1024), pa2 = *(const bf16x8*)(ps + 2048), pa3 = *(const bf16x8*)(ps + 3072);
      const bf16x8 pb0 = *(const bf16x8*)(ps + 4096), pb1 = *(const bf16x8*)(ps + 4096 + 1024), pb2 = *(const bf16x8*)(ps + 4096 + 2048), pb3 = *(const bf16x8*)(ps + 4096 + 3072);
      const float al_a = al[r32], al_b = al[32 + r32];
      SBAR();
      if (j + 1 < NT) DMA_K(j + 1, (j + 1) & 1);
      if (j < NT) DMA_V(j, j & 1);
      if (j >= 1) {
        if (__any(al_a < 1.f) || __any(al_b < 1.f)) {
#pragma unroll
          for (int rb = 0; rb < 2; ++rb)
#pragma unroll
            for (int d = 0; d < 4; ++d)
#pragma unroll
              for (int r = 0; r < 16; ++r) o[rb][d][r] *= al[rb * 32 + crow(r, hi)]; }
        const int vb = vrb + ((j - 1) & 1) * 32768 + ch * 16384;
        pv_two<0>(o[0][0], o[1][0], vb, pa0, pa1, pa2, pa3, pb0, pb1, pb2, pb3); pv_two<1>(o[0][1], o[1][1], vb, pa0, pa1, pa2, pa3, pb0, pb1, pb2, pb3);
        pv_two<2>(o[0][2], o[1][2], vb, pa0, pa1, pa2, pa3, pb0, pb1, pb2, pb3); pv_two<3>(o[0][3], o[1][3], vb, pa0, pa1, pa2, pa3, pb0, pb1, pb2, pb3);
      }
      asm volatile("s_waitcnt vmcnt(0)" ::: "memory");
      __syncthreads();
    }
    __syncthreads();
#pragma unroll
    for (int rb = 0; rb < 2; ++rb) {
      float rli[16];
#pragma unroll
      for (int r = 0; r < 16; ++r) rli[r] = __builtin_amdgcn_rcpf(ll0[rb * 32 + crow(r, hi)]);
      bf16* Ow = Ob + (long)(64 * rp + 32 * rb) * LD + ch * 128;
#pragma unroll
      for (int r = 0; r < 16; ++r) { const int orow = crow(r, hi);
#pragma unroll
        for (int d0 = 0; d0 < 4; ++d0) { const unsigned w_ = cvt_pk_bf16(o[rb][d0][r] * rli[r], 0.f); Ow[(long)orow * LD + d0 * 32 + r32] = (bf16)(w_ & 0xffffu); } } }
  }
#undef DMA_K
#undef DMA_V
}

__device__ __forceinline__ void attn_sample_unit(int b, int h, int split, const bf16* __restrict__ Q, const float* __restrict__ cache_k, const float* __restrict__ cache_v,
                                                 const float* __restrict__ newk, const float* __restrict__ newv, float* __restrict__ part, const float* lut, char* lds, float* scr) {
  const int tid = opaque_tid(), wid = __builtin_amdgcn_readfirstlane(tid >> 6), lane = tid & 63, r32 = lane & 31, hi = lane >> 5;
  const int nT = split ? 33 : 32;
  if (wid >= 4) {
    const int lw = wid - 4;
    f32x4 kreg[16], vreg[16];
#define SL_LOAD(j) do { const bool isnew = ((j) == 32); \
      const float* kp = isnew ? newk + ((size_t)b * 16 + lw) * 2048 + h * 256 + lane * 4 : cache_k + ((size_t)b * 4096 + (size_t)split * 2048 + (size_t)(j) * 64 + lw) * 2048 + h * 256 + lane * 4; \
      const float* vp = isnew ? newv + ((size_t)b * 16 + lw) * 2048 + h * 256 + lane * 4 : cache_v + ((size_t)b * 4096 + (size_t)split * 2048 + (size_t)(j) * 64 + lw) * 2048 + h * 256 + lane * 4; \
      _Pragma("unroll") for (int i = 0; i < 16; ++i) { \
        if (!isnew || i < 4) { kreg[i] = __builtin_nontemporal_load(reinterpret_cast<const f32x4*>(kp)); vreg[i] = __builtin_nontemporal_load(reinterpret_cast<const f32x4*>(vp)); } \
        else { kreg[i] = (f32x4){0.f, 0.f, 0.f, 0.f}; vreg[i] = (f32x4){0.f, 0.f, 0.f, 0.f}; } \
        kp += 4 * 2048; vp += 4 * 2048; asm volatile("" : "+v"(kp), "+v"(vp)); } } while (0)
#define SL_WRITE(bufi) do { char* bb = lds + (bufi) * 65536; _Pragma("unroll") for (int i = 0; i < 16; ++i) { const int key = i * 4 + lw; \
      const int c = lane >> 5, db = (lane & 31) * 8; \
      u32x2 kw; kw.x = cvt_pk_bf16(kreg[i][0], kreg[i][1]); kw.y = cvt_pk_bf16(kreg[i][2], kreg[i][3]); \
      *reinterpret_cast<u32x2*>(bb + c * 16384 + KSWZ(key, db & ~15) + (db & 15)) = kw; \
      const int e = lane * 4, vh = e >> 7, cc = e & 127; \
      u32x2 vw; vw.x = cvt_pk_bf16(vreg[i][0], vreg[i][1]); vw.y = cvt_pk_bf16(vreg[i][2], vreg[i][3]); \
      *reinterpret_cast<u32x2*>(bb + 32768 + vh * 16384 + v_st(key, cc & ~7) + (cc & 7) * 2) = vw; } } while (0)
    SL_LOAD(0); SL_WRITE(0); SL_LOAD(1);
    __syncthreads();
    for (int j = 0; j < nT; ++j) {
      if (j + 1 < nT) { SL_WRITE((j + 1) & 1); if (j + 2 < nT) SL_LOAD(j + 2); }
      __syncthreads();
    }
#undef SL_LOAD
#undef SL_WRITE
  } else {
    const int c = wid & 1, vh = wid >> 1;
    float* li_l = scr + wid * 64; float* al_l = li_l + 32;
    float m_reg = -1e30f, l_reg = 0; f32x16 o[4] = {};
    const bf16* Qw = Q + (size_t)(MP + b * 16 + (r32 & 15)) * LD + h * 256 + c * 128 + hi * 8;
    __syncthreads();
    for (int j = 0; j < nT; ++j) {
      char* bb = lds + (j & 1) * 65536;
      f32x16 p0, p1; float mn, al; bf16x8 pa0, pa1, pa2, pa3; bf16x8 qr[8];
      asm volatile("" : "+v"(Qw));
#pragma unroll
      for (int d0 = 0; d0 < 8; ++d0) { bf16x8 v = *reinterpret_cast<const bf16x8*>(Qw + d0 * 16); if (r32 >= 16) v = (bf16x8){0, 0, 0, 0, 0, 0, 0, 0}; qr[d0] = v; }
      qkt(p0, p1, bb + c * 16384, qr, r32, hi);
      const int kbase = (j == 32) ? 4096 : split * 2048 + j * 64;
      if (kbase >= 3904) {
        const float* lp = lut + (kbase - (4096 + r32) + 192);
#pragma unroll
        for (int r = 0; r < 16; ++r) { p0[r] += lp[crow(r, hi)]; p1[r] += lp[32 + crow(r, hi)]; }
      }
      if (j == 32) {
#pragma unroll
        for (int r = 0; r < 16; ++r) { if (crow(r, hi) >= 16) p0[r] = -1e30f; p1[r] = -1e30f; }
      }
      partialSM(p0, p1, m_reg, mn, al);
      RESC(al);
      finishSM(p0, p1, al, l_reg, pa0, pa1, pa2, pa3); SBAR();
      pv_d0(o, (int)(uintptr_t)(bb + 32768 + vh * 16384) + v_rd_base(lane), pa0, pa1, pa2, pa3);
      __syncthreads();
    }
    float* pp = part + (size_t)((((b * 8 + h) * 2 + split) * 4) + c * 2 + vh) * 2112;
    if (hi == 0 && r32 < 16) { pp[r32] = m_reg; pp[16 + r32] = l_reg; }
#pragma unroll
    for (int d0 = 0; d0 < 4; ++d0)
#pragma unroll
      for (int r = 0; r < 8; ++r) pp[64 + crow(r, hi) * 128 + d0 * 32 + r32] = o[d0][r];
  }
#undef RESC
}
}

namespace hg {
constexpr int QG_OFF = 0, KG_OFF = 8704, KDT_OFF = 17408, DL_OFF = 25600, SSQP_OFF = 26624, ROWB = 272, RAW_OFF = 28672, RAW_SLOT = 20480;
__device__ __forceinline__ void row_prefix4(float x, int tq, float& pre, float& tot) {
    const auto s16 = __builtin_amdgcn_permlane16_swap(__float_as_uint(x), __float_as_uint(x), false, false);
    const float ev = __uint_as_float(s16[0]), od = __uint_as_float(s16[1]), pr = ev + od;
    const auto s32 = __builtin_amdgcn_permlane32_swap(__float_as_uint(pr), __float_as_uint(pr), false, false);
    const float lo = __uint_as_float(s32[0]), hi = __uint_as_float(s32[1]);
    tot = lo + hi; pre = tq == 0 ? 0.f : tq == 1 ? ev : tq == 2 ? lo : lo + ev;
}
template <bool FULL>
__device__ __forceinline__ void hgrn_prep(char* lds, int s, int w, int kc, int tq, int kpos, float& gsum, s16x4& vfrag, u32x2& gvp) {
    const int buf = s & 1;
    char* QG = lds + QG_OFF + buf * 4352; char* KG = lds + KG_OFF + buf * 4352; char* KDT = lds + KDT_OFF + buf * 4096;
    float* DL = (float*)(lds + DL_OFF + buf * 512);
    const char* raw = lds + RAW_OFF + buf * RAW_SLOT;
    float lf[4]; unsigned short qv[4], vv[4], gv[4];
#pragma unroll
    for (int j = 0; j < 4; ++j) { const int e = (4 * tq + j) * 128 + 16 * w + kc; lf[j] = h2f(*(const unsigned short*)(raw + e * 2)); vv[j] = *(const unsigned short*)(raw + 12288 + e * 2);
        if (FULL) { qv[j] = *(const unsigned short*)(raw + 8192 + e * 2); gv[j] = *(const unsigned short*)(raw + 16384 + e * 2); } }
    float G[4], glast;
    { const float c0 = lf[0], c1 = c0 + lf[1], c2 = c1 + lf[2], c3 = c2 + lf[3];
      float pre; row_prefix4(c3, tq, pre, glast);
      G[0] = pre + c0; G[1] = pre + c1; G[2] = pre + c2; G[3] = pre + c3; }
    float kd[4];
#pragma unroll
    for (int j = 0; j < 4; ++j) { const float kk = 1.f - __builtin_amdgcn_exp2f(lf[j]);
        kd[j] = kk * __builtin_amdgcn_exp2f(glast - G[j]);
        if (FULL) { const float qg = bf2f(qv[j]) * __builtin_amdgcn_exp2f(G[j]), kg = kk * __builtin_amdgcn_exp2f(fminf(-G[j], 115.f));
            const unsigned qk = cvt_pk_bf16(qg, kg);
            *(bf16*)(QG + (4 * tq + j) * ROWB + kpos * 2) = (bf16)(qk & 0xffffu);
            *(bf16*)(KG + (4 * tq + j) * ROWB + kpos * 2) = (bf16)(qk >> 16); }
        vfrag[j] = (short)vv[j]; }
    { u32x2 kw; kw.x = cvt_pk_bf16(kd[0], kd[1]); kw.y = cvt_pk_bf16(kd[2], kd[3]); *(u32x2*)(KDT + ((16 * w + kc) * 16 + 4 * tq) * 2) = kw; }
    DL[16 * w + kc] = __builtin_amdgcn_exp2f(glast);
    gsum += glast;
    if (FULL) { gvp.x = (unsigned)gv[0] | ((unsigned)gv[1] << 16); gvp.y = (unsigned)gv[2] | ((unsigned)gv[3] << 16); }
}
template <bool FULL>
__device__ __forceinline__ void hgrn_mma(char* lds, int s, int w, int kc, int tq, const s16x4 vfrag, f32x4 (&S)[8], f32x4& o) {
    const int buf = s & 1;
    const char* QG = lds + QG_OFF + buf * 4352; const char* KG = lds + KG_OFF + buf * 4352; const char* KDT = lds + KDT_OFF + buf * 4096;
    const float* DL = (const float*)(lds + DL_OFF + buf * 512); float* SSQP = (float*)(lds + SSQP_OFF + buf * 512);
    o = (f32x4){0.f, 0.f, 0.f, 0.f};
    if (FULL) {
        f32x4 st = {0.f, 0.f, 0.f, 0.f};
#pragma unroll
        for (int ks = 0; ks < 4; ++ks) {
            const bf16x8 qa = *(const bf16x8*)(QG + kc * ROWB + (32 * ks + 8 * tq) * 2), ka = *(const bf16x8*)(KG + kc * ROWB + (32 * ks + 8 * tq) * 2);
            u32x4 sw; sw.x = cvt_pk_bf16(S[2 * ks][0], S[2 * ks][1]); sw.y = cvt_pk_bf16(S[2 * ks][2], S[2 * ks][3]);
            sw.z = cvt_pk_bf16(S[2 * ks + 1][0], S[2 * ks + 1][1]); sw.w = cvt_pk_bf16(S[2 * ks + 1][2], S[2 * ks + 1][3]);
            o = __builtin_amdgcn_mfma_f32_16x16x32_bf16(qa, *reinterpret_cast<bf16x8*>(&sw), o, 0, 0, 0);
            st = __builtin_amdgcn_mfma_f32_16x16x32_bf16(ka, qa, st, 0, 0, 0); }
#pragma unroll
        for (int i = 0; i < 4; ++i) st[i] = (4 * tq + i <= kc) ? st[i] : 0.f;
        u32x2 sp; sp.x = cvt_pk_bf16(st[0], st[1]); sp.y = cvt_pk_bf16(st[2], st[3]);
        o = __builtin_amdgcn_mfma_f32_16x16x16bf16_1k(*reinterpret_cast<s16x4*>(&sp), vfrag, o, 0, 0, 0);
    }
#pragma unroll
    for (int kb = 0; kb < 8; ++kb) { const f32x4 dlv = *(const f32x4*)(DL + 16 * kb + 4 * tq);
        const s16x4 ka = *(const s16x4*)(KDT + ((16 * kb + kc) * 16 + 4 * tq) * 2);
        S[kb] = __builtin_amdgcn_mfma_f32_16x16x16bf16_1k(ka, vfrag, S[kb] * dlv, 0, 0, 0); }
    if (FULL) {
        float ss[4];
#pragma unroll
        for (int i = 0; i < 4; ++i) ss[i] = row16_sum(o[i] * o[i]);
#pragma unroll
        for (int i = 0; i < 4; ++i) SSQP[(4 * tq + i) * 8 + w] = ss[i];
    }
}
__device__ __forceinline__ void hgrn_fin(char* lds, int s, int w, int kc, int tq, int ch, int row0, float gn, const f32x4 o, const u32x2 gvp, bf16* __restrict__ O) {
    const float* SSQP = (const float*)(lds + SSQP_OFF + (s & 1) * 512);
#pragma unroll
    for (int i = 0; i < 4; ++i) { const float part = SSQP[(4 * tq + i) * 8 + (kc & 7)];
        const float tot = row16_sum(kc < 8 ? part : 0.f);
        const float rs = __builtin_amdgcn_rsqf(tot * (1.f / 128.f) + EPS);
        const unsigned gw_ = i < 2 ? gvp.x : gvp.y; const float gate = __uint_as_float((i & 1) ? (gw_ & 0xffff0000u) : (gw_ << 16));
        const float ov = o[i] * rs * gn * gate;
        O[(size_t)(row0 + 16 * s + 4 * tq + i) * D + ch] = (bf16)(cvt_pk_bf16(ov, 0.f) & 0xffffu); }
}
template <bool FULL, bool SBF>
__device__ __forceinline__ void hgrn_item(const bf16* __restrict__ Q, const float* __restrict__ LOGF, const bf16* __restrict__ V, const bf16* __restrict__ GS, bf16* __restrict__ O,
                                          int row0, int nsteps, int h, const void* __restrict__ Sin, void* __restrict__ Sout, float* __restrict__ Dout, const float* __restrict__ gain, char* lds) {
    const int tid = opaque_tid(), w = __builtin_amdgcn_readfirstlane(tid >> 6), lane = tid & 63, kc = lane & 15, tq = lane >> 4;
    const int ch = h * 128 + 16 * w + kc;
    const int kpos = 32 * (w >> 1) + 8 * (kc >> 2) + 4 * (w & 1) + (kc & 3);
    f32x4 S[8];
#pragma unroll
    for (int kb = 0; kb < 8; ++kb)
#pragma unroll
        for (int i = 0; i < 4; ++i) { const size_t so = (size_t)(16 * kb + 4 * tq + i) * 128 + 16 * w + kc; S[kb][i] = Sin ? (SBF ? bf2f(((const bf16*)Sin)[so]) : ((const float*)Sin)[so]) : 0.f; }
    float gsum = 0.f;
    const int t2 = tid & 255; const bool lo4 = tid < 256;
    const unsigned short* plf = (const unsigned short*)LOGF + (size_t)(row0 + (tid >> 5)) * D + h * 128 + 4 * (tid & 31);
    const size_t boff = (size_t)(row0 + (t2 >> 4)) * D + h * 128 + 8 * (t2 & 15);
    const bf16* pb0 = (lo4 ? Q : V) + boff; const bf16* pb1 = GS + boff;
    u32x2 rl[3]; bf16x8 rb0[3], rb1[3];
#define HG_LOAD(j, s_) do { rl[j] = *(const u32x2*)(plf + (size_t)(s_) * 16 * D); if (FULL || !lo4) rb0[j] = *(const bf16x8*)(pb0 + (size_t)(s_) * 16 * D); if (FULL && lo4) rb1[j] = *(const bf16x8*)(pb1 + (size_t)(s_) * 16 * D); } while (0)
#define HG_WRITE(j, slot) do { char* rb = lds + RAW_OFF + (slot) * RAW_SLOT; *(u32x2*)(rb + tid * 8) = rl[j]; \
        if (lo4) { if (FULL) { *(bf16x8*)(rb + 8192 + t2 * 16) = rb0[j]; *(bf16x8*)(rb + 16384 + t2 * 16) = rb1[j]; } } else *(bf16x8*)(rb + 12288 + t2 * 16) = rb0[j]; } while (0)
    const float gn = FULL ? gain[16 * w + kc] : 0.f;
    s16x4 vf_cur, vf_nxt; u32x2 gv_cur = {0u, 0u}, gv_nxt = {0u, 0u}, gv_prev = {0u, 0u}; f32x4 o_prev = {0.f, 0.f, 0.f, 0.f};
    HG_LOAD(0, 0); if (1 < nsteps) HG_LOAD(1, 1); if (2 < nsteps) HG_LOAD(2, 2);
    HG_WRITE(0, 0); if (1 < nsteps) HG_WRITE(1, 1);
    if (3 < nsteps) HG_LOAD(0, 3); if (4 < nsteps) HG_LOAD(1, 4);
    LDS_WAIT(); __builtin_amdgcn_s_barrier(); asm volatile("" ::: "memory");
    hgrn_prep<FULL>(lds, 0, w, kc, tq, kpos, gsum, vf_cur, gv_cur);
    LDS_WAIT(); __builtin_amdgcn_s_barrier(); asm volatile("" ::: "memory");
#define HG_STEP(j) do { const int s = s3 + (j); if (s < nsteps) { f32x4 o_s; \
        hgrn_mma<FULL>(lds, s, w, kc, tq, vf_cur, S, o_s); \
        if (s + 1 < nsteps) hgrn_prep<FULL>(lds, s + 1, w, kc, tq, kpos, gsum, vf_nxt, gv_nxt); \
        if (FULL && s >= 1) hgrn_fin(lds, s - 1, w, kc, tq, ch, row0, gn, o_prev, gv_prev, O); \
        if (s + 2 < nsteps) HG_WRITE(((j) + 2) % 3, s & 1); \
        if (s + 5 < nsteps) HG_LOAD(((j) + 2) % 3, s + 5); \
        LDS_WAIT(); __builtin_amdgcn_s_barrier(); asm volatile("" ::: "memory"); \
        o_prev = o_s; gv_prev = gv_cur; vf_cur = vf_nxt; gv_cur = gv_nxt; } } while (0)
#pragma unroll 1
    for (int s3 = 0; s3 < nsteps; s3 += 3) { HG_STEP(0); HG_STEP(1); HG_STEP(2); }
    if (FULL) hgrn_fin(lds, nsteps - 1, w, kc, tq, ch, row0, gn, o_prev, gv_prev, O);
    if (Sout) {
#pragma unroll
        for (int kb = 0; kb < 8; ++kb)
#pragma unroll
            for (int i = 0; i < 4; ++i) { const size_t so = (size_t)(16 * kb + 4 * tq + i) * 128 + 16 * w + kc; if (SBF) ((bf16*)Sout)[so] = (bf16)(cvt_pk_bf16(S[kb][i], 0.f) & 0xffffu); else ((float*)Sout)[so] = S[kb][i]; } }
    if (!FULL && Dout && tq == 0) Dout[16 * w + kc] = __builtin_amdgcn_exp2f(gsum);
    LDS_WAIT(); __builtin_amdgcn_s_barrier(); asm volatile("" ::: "memory");
#undef HG_LOAD
#undef HG_WRITE
#undef HG_STEP
}
__device__ __forceinline__ void hgrn_prep64(char* lds, int s, int w, int kc, int tq, float& gsum, bf16x8 (&vf)[2]) {
    const int buf = s & 1; const char* raw = lds + buf * 49152; char* KDT = lds + 98304 + buf * 16384; float* DL = (float*)(lds + 131072 + buf * 512);
    const int ch = 16 * w + kc;
    float lf[2][8];
#pragma unroll
    for (int hf = 0; hf < 2; ++hf)
#pragma unroll
        for (int jj = 0; jj < 8; ++jj) { const int t = 32 * hf + 8 * tq + jj; lf[hf][jj] = h2f(*(const unsigned short*)(raw + (t * 128 + ch) * 2));
            vf[hf][jj] = (short)*(const unsigned short*)(raw + 32768 + (t * 128 + ch) * 2); }
    float c[2][8];
#pragma unroll
    for (int hf = 0; hf < 2; ++hf) { c[hf][0] = lf[hf][0];
#pragma unroll
        for (int jj = 1; jj < 8; ++jj) c[hf][jj] = c[hf][jj - 1] + lf[hf][jj]; }
    const float R0 = c[0][7], R1 = c[1][7];
    float P0, T0, p1_, t1_; row_prefix4(R0, tq, P0, T0); row_prefix4(R1, tq, p1_, t1_);
    const float P1 = T0 + p1_, glast = T0 + t1_;
#pragma unroll
    for (int hf = 0; hf < 2; ++hf) { const float P = hf ? P1 : P0; float kd[8];
#pragma unroll
        for (int jj = 0; jj < 8; ++jj) kd[jj] = (1.f - __builtin_amdgcn_exp2f(lf[hf][jj])) * __builtin_amdgcn_exp2f(glast - (P + c[hf][jj]));
        u32x4 kw; kw.x = cvt_pk_bf16(kd[0], kd[1]); kw.y = cvt_pk_bf16(kd[2], kd[3]); kw.z = cvt_pk_bf16(kd[4], kd[5]); kw.w = cvt_pk_bf16(kd[6], kd[7]);
        *(u32x4*)(KDT + ch * 128 + (((4 * hf + tq) ^ (ch & 7)) << 4)) = kw; }
    DL[ch] = __builtin_amdgcn_exp2f(glast);
    gsum += glast;
}
__device__ __forceinline__ void hgrn_mma64(char* lds, int s, int kc, int tq, const bf16x8 (&vf)[2], f32x4 (&S)[8]) {
    const int buf = s & 1; const char* KDT = lds + 98304 + buf * 16384; const float* DL = (const float*)(lds + 131072 + buf * 512);
#pragma unroll
    for (int kb = 0; kb < 8; ++kb) { const f32x4 dlv = *(const f32x4*)(DL + 16 * kb + 4 * tq); const int kr = 16 * kb + kc;
        const bf16x8 k0 = *(const bf16x8*)(KDT + kr * 128 + ((tq ^ (kr & 7)) << 4)), k1 = *(const bf16x8*)(KDT + kr * 128 + (((4 + tq) ^ (kr & 7)) << 4));
        f32x4 acc = S[kb] * dlv;
        acc = __builtin_amdgcn_mfma_f32_16x16x32_bf16(k0, vf[0], acc, 0, 0, 0);
        S[kb] = __builtin_amdgcn_mfma_f32_16x16x32_bf16(k1, vf[1], acc, 0, 0, 0); }
}
__device__ __forceinline__ void hgrn_state_item64(const float* __restrict__ LOGF, const bf16* __restrict__ V, int row0, int nsteps, int h, bf16* __restrict__ Sout, float* __restrict__ Dout, char* lds) {
    const int tid = opaque_tid(), w = __builtin_amdgcn_readfirstlane(tid >> 6), lane = tid & 63, kc = lane & 15, tq = lane >> 4;
    f32x4 S[8];
#pragma unroll
    for (int kb = 0; kb < 8; ++kb) S[kb] = (f32x4){0.f, 0.f, 0.f, 0.f};
    float gsum = 0.f;
    const char* glf = (const char*)((const unsigned short*)LOGF + (size_t)(row0 + 8 * w + (lane >> 4)) * D + h * 128 + 8 * (lane & 15));
    const char* gv = (const char*)(V + (size_t)(row0 + 8 * w + (lane >> 4)) * D + h * 128 + 8 * (lane & 15));
    LAS char* ll = (LAS char*)lds;
#define HG_DMA(s_, slot) do { _Pragma("unroll") for (int i = 0; i < 2; ++i) \
        __builtin_amdgcn_global_load_lds((const unsigned*)(glf + ((size_t)(s_) * 64 + 4 * i) * (D * 2)), (LAS unsigned*)(ll + (slot) * 49152 + (8 * w + 4 * i) * 256), 16, 0, 0); \
      _Pragma("unroll") for (int i = 0; i < 2; ++i) \
        __builtin_amdgcn_global_load_lds((const unsigned*)(gv + ((size_t)(s_) * 64 + 4 * i) * (D * 2)), (LAS unsigned*)(ll + (slot) * 49152 + 32768 + (8 * w + 4 * i) * 256), 16, 0, 0); } while (0)
    bf16x8 vf_cur[2], vf_nxt[2];
    HG_DMA(0, 0); if (1 < nsteps) HG_DMA(1, 1);
    asm volatile("s_waitcnt vmcnt(0)" ::: "memory"); __builtin_amdgcn_s_barrier(); asm volatile("" ::: "memory");
    hgrn_prep64(lds, 0, w, kc, tq, gsum, vf_cur);
    LDS_WAIT(); __builtin_amdgcn_s_barrier(); asm volatile("" ::: "memory");
#pragma unroll 1
    for (int s = 0; s < nsteps; ++s) {
        if (s + 2 < nsteps) HG_DMA(s + 2, s & 1);
        hgrn_mma64(lds, s, kc, tq, vf_cur, S);
        if (s + 1 < nsteps) hgrn_prep64(lds, s + 1, w, kc, tq, gsum, vf_nxt);
        asm volatile("s_waitcnt vmcnt(0) lgkmcnt(0)" ::: "memory"); __builtin_amdgcn_s_barrier(); asm volatile("" ::: "memory");
        vf_cur[0] = vf_nxt[0]; vf_cur[1] = vf_nxt[1];
    }
#undef HG_DMA
#pragma unroll
    for (int kb = 0; kb < 8; ++kb)
#pragma unroll
        for (int i = 0; i < 4; ++i) Sout[(size_t)(16 * kb + 4 * tq + i) * 128 + 16 * w + kc] = (bf16)(cvt_pk_bf16(S[kb][i], 0.f) & 0xffffu);
    if (tq == 0) Dout[16 * w + kc] = __builtin_amdgcn_exp2f(gsum);
    LDS_WAIT(); __builtin_amdgcn_s_barrier(); asm volatile("" ::: "memory");
}
}

__device__ __forceinline__ float row_scale_any(const float* ssq, const float* ssqS, int row) { return row < MP ? pg8::row_scale(ssq, row) : sk::row_scale_s(ssqS, row - MP); }
__device__ __forceinline__ f32x4 ldx4(const bf16* p) { const u32x2 w = *(const u32x2*)p; return (f32x4){__uint_as_float(w.x << 16), __uint_as_float(w.x & 0xffff0000u), __uint_as_float(w.y << 16), __uint_as_float(w.y & 0xffff0000u)}; }
template <int W>
__device__ __forceinline__ void pool_tile(const bf16* __restrict__ X, const float* __restrict__ ssq, const float* __restrict__ ssqS, const float* __restrict__ gain, const float* __restrict__ hist, int histmode,
                                          int xrow0, int nt, int pos0, bf16* __restrict__ P, float* __restrict__ newpool, int np_first, int c4) {
    const f32x4 gv = *(const f32x4*)(gain + c4);
    f32x4 ring[16], wsum = {0.f, 0.f, 0.f, 0.f};
#pragma unroll
    for (int i = 0; i < 16; ++i) ring[i] = (f32x4){0.f, 0.f, 0.f, 0.f};
#pragma unroll
    for (int i = 1; i < 16; ++i) { const int r = -16 + i; f32x4 val = {0.f, 0.f, 0.f, 0.f};
        if (histmode == 0) { const int row = xrow0 + r; const float rs = row_scale_any(ssq, ssqS, row); val = ldx4(X + (size_t)row * D + c4) * rs * gv; }
        else if (histmode == 2) val = *(const f32x4*)(hist + (size_t)(r + 15) * D + c4);
        wsum += val - ring[(i - W + 16) & 15]; ring[i] = val; }
    for (int blk = 0; blk < nt / 16; ++blk) {
#pragma unroll
        for (int i = 0; i < 16; ++i) { const int r = 16 * blk + i, row = xrow0 + r; const float rs = row_scale_any(ssq, ssqS, row);
            const f32x4 val = ldx4(X + (size_t)row * D + c4) * rs * gv;
            wsum += val - ring[(i - W + 16) & 15]; ring[i] = val;
            const int cnt = (pos0 + r + 1) < W ? (pos0 + r + 1) : W; const float ic = 1.0f / (float)cnt;
            const f32x4 pv = wsum * ic - val;
            u32x2 pw; pw.x = cvt_pk_bf16(pv[0], pv[1]); pw.y = cvt_pk_bf16(pv[2], pv[3]);
            *(u32x2*)(P + (size_t)row * D + c4) = pw;
            if (newpool && r >= np_first) *(f32x4*)(newpool + (size_t)(r - np_first) * D + c4) = val; }
    }
}

#define XB_TMO      128
#define XB_XCNT(j)  (256  + 64 * (j))
#define XB_XSUB(j)  (1280 + 64 * (j))
#define XB_XGEN(j)  (2304 + 64 * (j))
#define XB_TOP      3328
#define XB_TOPGEN   3392
#define XCD_BAR_WORDS 3456
#define XB_SPIN_CAP (1u << 18)
__device__ __forceinline__ unsigned xb_ld(unsigned* p)              { return __hip_atomic_load(p, __ATOMIC_RELAXED, __HIP_MEMORY_SCOPE_AGENT); }
__device__ __forceinline__ unsigned xb_add(unsigned* p, unsigned v) { return __hip_atomic_fetch_add(p, v, __ATOMIC_RELAXED, __HIP_MEMORY_SCOPE_AGENT); }
__device__ __forceinline__ unsigned xb_xcc_id() { return (unsigned)__builtin_amdgcn_s_getreg((3 << 11) | 20) & 0xFu; }
#define XB_SPIN(cond, bar) do { unsigned _sp = 0; while (cond) { __builtin_amdgcn_s_sleep(1); \
    if ((++_sp & 255u) == 0u) { if (xb_ld(&(bar)[XB_TMO])) break; if (_sp > XB_SPIN_CAP) { atomicAdd(&(bar)[XB_TMO], 1u); break; } } } } while (0)
struct XcdBarrier { unsigned* bar; unsigned x; volatile LAS unsigned* st; };
__device__ __forceinline__ XcdBarrier xcd_barrier_post(unsigned* bar, volatile LAS unsigned* st) {
    XcdBarrier b; b.bar = bar; b.x = xb_xcc_id(); b.st = st;
    if (threadIdx.x == 0) (void)xb_add(&bar[XB_XCNT(b.x)], 1u);
    return b;
}
__device__ __forceinline__ void xcd_barrier_complete(unsigned* bar, unsigned x, unsigned& nloc, unsigned& nx) {
    const unsigned G = gridDim.x * gridDim.y * gridDim.z;
    unsigned sum, cnt, mine, sp = 0u;
    for (;;) {
        sum = 0u; cnt = 0u; mine = 0u;
#pragma unroll
        for (unsigned j = 0; j < 16; ++j) { const unsigned c = xb_ld(&bar[XB_XCNT(j)]); sum += c; cnt += (c > 0u) ? 1u : 0u; mine = (j == x) ? c : mine; }
        if (sum == G) break;
        __builtin_amdgcn_s_sleep(1);
        if ((++sp & 255u) == 0u) { if (xb_ld(&bar[XB_TMO])) break; if (sp > XB_SPIN_CAP) { atomicAdd(&bar[XB_TMO], 1u); break; } }
    }
    nloc = mine > 0u ? mine : 1u; nx = cnt > 0u ? cnt : 1u;
}
__device__ __forceinline__ void xcd_barrier(const XcdBarrier& b) {
    asm volatile("s_waitcnt vmcnt(0)" ::: "memory");
    __syncthreads();
    if (threadIdx.x == 0) {
        unsigned* bar = b.bar;
        __builtin_amdgcn_s_waitcnt(0);
        unsigned nloc = b.st[0], nx = b.st[1];
        if (nloc == 0u) { xcd_barrier_complete(bar, b.x, nloc, nx); b.st[0] = nloc; b.st[1] = nx; }
        const unsigned old = xb_add(&bar[XB_XSUB(b.x)], 1u);
        const unsigned gen = old / nloc;
        if (old + 1u == (gen + 1u) * nloc) {
            __builtin_amdgcn_fence(__ATOMIC_RELEASE, "agent");
            asm volatile("s_waitcnt vmcnt(0)" ::: "memory");
            const unsigned og = xb_add(&bar[XB_TOP], 1u);
            const unsigned tg = og / nx;
            if (og + 1u == (tg + 1u) * nx) xb_add(&bar[XB_TOPGEN], 1u);
            else XB_SPIN(xb_ld(&bar[XB_TOPGEN]) == tg, bar);
            __builtin_amdgcn_fence(__ATOMIC_ACQUIRE, "agent");
            xb_add(&bar[XB_XGEN(b.x)], 1u);
            asm volatile("s_waitcnt vmcnt(0)" ::: "memory");
        } else {
            XB_SPIN(xb_ld(&bar[XB_XGEN(b.x)]) == gen, bar);
            __builtin_amdgcn_fence(__ATOMIC_ACQUIRE, "agent");
            asm volatile("s_waitcnt vmcnt(0)" ::: "memory");
        }
    }
    __syncthreads();
}

struct Args { const float* in[31]; float* out; unsigned char* ws; int lo, hi; };
enum { I_XP = 0, I_XS, I_SHG, I_SPL, I_CK, I_CV, I_NMIX, I_NFFN, I_NFIN, I_HWQ, I_HWF, I_HWI, I_HWG, I_HWO, I_HLB, I_HGAIN, I_PW, I_PSC, I_AWQ, I_AWK, I_AWV, I_AWO,
       I_LQ1, I_LK1, I_LQ2, I_LK2, I_SUBG, I_REL, I_FG, I_FU, I_FD };
constexpr int PH_END = 42;

__device__ __forceinline__ void cvt_item(const float* __restrict__ W, int N, bf16* __restrict__ WT, int K, int k0, int n0, int drow, const float* __restrict__ gain, LAS float* scr, int lane) {
    const int sub = lane >> 3, ch = lane & 7;
    f32x4 v[8];
#pragma unroll
    for (int i = 0; i < 8; ++i) v[i] = *(const f32x4*)(W + (size_t)(k0 + 8 * i + sub) * N + n0 + 4 * ch);
#pragma unroll
    for (int i = 0; i < 8; ++i) { const int kk = 8 * i + sub; const float gm = gain ? gain[k0 + kk] : 1.f; LAS float* d = scr + kk * 33 + 4 * ch;
        d[0] = v[i][0] * gm; d[1] = v[i][1] * gm; d[2] = v[i][2] * gm; d[3] = v[i][3] * gm; }
    LDS_WAIT(); asm volatile("" ::: "memory");
    const int c = lane & 7;
#pragma unroll
    for (int j = 0; j < 4; ++j) { const int n = (lane >> 3) + 8 * j; const LAS float* s = scr + (8 * c) * 33 + n;
        u32x4 o; o.x = cvt_pk_bf16(s[0 * 33], s[1 * 33]); o.y = cvt_pk_bf16(s[2 * 33], s[3 * 33]); o.z = cvt_pk_bf16(s[4 * 33], s[5 * 33]); o.w = cvt_pk_bf16(s[6 * 33], s[7 * 33]);
        *(u32x4*)(WT + (size_t)(drow + n) * K + k0 + 8 * c) = o; }
    LDS_WAIT(); asm volatile("" ::: "memory");
}
__device__ __forceinline__ void cvt_matrix(const float* W, int K, int N, bf16* WT, int mode, int row_off, const float* gain, LAS float* scr, int gw, int ngw, int lane) {
    const int nblk = N / 32, items = (K / 64) * nblk;
    for (int it = gw; it < items; it += ngw) { const int kb = it / nblk, nb = it % nblk, n0 = 32 * nb;
        const int drow = mode ? ((n0 >> 7) * 256 + row_off + (n0 & 127)) : (row_off + n0);
        cvt_item(W, N, WT, K, 64 * kb, n0, drow, gain, scr, lane); }
}
__device__ __forceinline__ int rel_bucket(int rel) {
    const int n = rel < 0 ? -rel : rel; int v;
    if (n < 8) v = n; else if (n < 12) v = 8; else if (n < 16) v = 9; else if (n < 23) v = 10; else if (n < 32) v = 11; else if (n < 46) v = 12; else if (n < 64) v = 13; else if (n < 91) v = 14; else v = 15;
    return (rel > 0 ? 16 : 0) + v;
}

typedef const __attribute__((address_space(4))) Args* CArgsP;
__global__ void __launch_bounds__(512, 2) fwd_kernel(Args a) {
    extern __shared__ __attribute__((aligned(16))) unsigned char lds_raw[];
    LAS unsigned char* lds = (LAS unsigned char*)lds_raw;
    char* ldsg = (char*)lds_raw;
    volatile LAS unsigned* MISC = (volatile LAS unsigned*)(lds + MISC_OFF);
    const int tid = threadIdx.x, lane = tid & 63, wave = __builtin_amdgcn_readfirstlane(tid >> 6);
    const int G0 = gridDim.x; const int vcu0 = (G0 % 8 == 0) ? ((int)blockIdx.x % 8) * (G0 / 8) + (int)blockIdx.x / 8 : (int)blockIdx.x;
    unsigned* ctl = (unsigned*)(a.ws + WS_CTL);
    if (tid < 32) MISC[tid] = 0u;
    __syncthreads();
    XcdBarrier bar = xcd_barrier_post(ctl + CW_BAR, MISC + 8);
    const int lo = a.lo, hi = a.hi;
#ifndef SITE_MASK
#define SITE_MASK 0xFFFFFFFFu
#endif
#define SITE(k) (((SITE_MASK) >> (k)) & 1u)
#define PHASE_ON(id) (lo <= (id) && (id) < hi)
#define PHASE_SYNC(id) do { if ((id) != lo) xcd_barrier(bar); } while (0)
#define PH_PTRS CArgsP ap = (CArgsP)__builtin_amdgcn_kernarg_segment_ptr(); asm volatile("" : "+s"(ap)); unsigned char* ws = ap->ws; float* out = ap->out; float* SSQ = (float*)(ws + WS_SSQ); float* CONSTS = (float*)(ws + WS_CONST); \
    float* X = (float*)(ws + WS_X); bf16* XB = (bf16*)(ws + WS_XB); bf16* A0 = (bf16*)(ws + WS_A0); bf16* A2 = (bf16*)(ws + WS_A2); bf16* A3 = (bf16*)(ws + WS_A3); bf16* A4 = (bf16*)(ws + WS_A4); \
    float* ssq_mix = SSQ + (size_t)(2 * layer) * M * 8; float* ssq_ffn = SSQ + (size_t)(2 * layer + 1) * M * 8; float* ssq_next = SSQ + (size_t)(2 * layer + 2) * M * 8; \
    float* SSQS = (float*)(ws + WS_SSQS); float* sq_mix = SSQS + (size_t)(2 * layer) * 16384; float* sq_ffn = SSQS + (size_t)(2 * layer + 1) * 16384; float* sq_next = SSQS + (size_t)(2 * layer + 2) * 16384; (void)sq_mix; (void)sq_ffn; (void)sq_next; \
    (void)out; (void)CONSTS; (void)X; (void)XB; (void)A0; (void)A2; (void)A3; (void)A4; (void)ssq_mix; (void)ssq_ffn; (void)ssq_next; \
    int G = G0, vcu = vcu0, bx = (int)blockIdx.x; asm volatile("" : "+s"(G), "+s"(vcu), "+s"(bx)); (void)bx; \
    const int tid = opaque_tid(), lane = tid & 63, wave = __builtin_amdgcn_readfirstlane(tid >> 6), gw = vcu * 8 + wave, ngw = G * 8; (void)lane; (void)gw; (void)ngw;

    if (SITE(0) && PHASE_ON(0)) { const int layer = 0; PH_PTRS
        LAS float* scr = (LAS float*)(lds + wave * 16384);
#pragma unroll 1
        for (int j = 0; j < 2; ++j) { const float* gmix = ap->in[I_NMIX] + (size_t)(3 * j) * D; bf16* wt = (bf16*)(ws + WS_HG0 + j * HG_STRIDE); const size_t wo = (size_t)j * D * D;
            cvt_matrix(ap->in[I_HWQ] + wo, D, D, wt, 0, 0, gmix, scr, gw, ngw, lane);
            cvt_matrix(ap->in[I_HWF] + wo, D, D, wt, 0, 2048, gmix, scr, gw, ngw, lane);
            cvt_matrix(ap->in[I_HWI] + wo, D, D, wt, 0, 4096, gmix, scr, gw, ngw, lane);
            cvt_matrix(ap->in[I_HWG] + wo, D, D, wt, 0, 6144, gmix, scr, gw, ngw, lane);
            cvt_matrix(ap->in[I_HWO] + wo, D, D, wt + (size_t)NHG * D, 0, 0, nullptr, scr, gw, ngw, lane); }
        { const float* gmix = ap->in[I_NMIX] + (size_t)2 * D; bf16* wt = (bf16*)(ws + WS_QKV);
            cvt_matrix(ap->in[I_AWQ], D, D, wt, 0, 0, gmix, scr, gw, ngw, lane);
            cvt_matrix(ap->in[I_AWK], D, D, wt, 0, 2048, gmix, scr, gw, ngw, lane);
            cvt_matrix(ap->in[I_AWV], D, D, wt, 0, 4096, gmix, scr, gw, ngw, lane);
            cvt_matrix(ap->in[I_AWO], D, D, (bf16*)(ws + WS_WOA), 0, 0, nullptr, scr, gw, ngw, lane); }
#pragma unroll 1
        for (int g4 = 0; g4 < 4; ++g4) cvt_matrix(ap->in[I_PW] + (size_t)g4 * 512 * 512, 512, 512, (bf16*)(ws + WS_WP), 0, g4 * 512, nullptr, scr, gw, ngw, lane);
#pragma unroll 1
        for (int i = 0; i < 4; ++i) { const float* gf = ap->in[I_NFFN] + (size_t)i * D; bf16* w1 = (bf16*)(ws + WS_W1 + i * FFN_STRIDE); bf16* w2 = (bf16*)(ws + WS_W1 + i * FFN_STRIDE + W2_OFF);
            cvt_matrix(ap->in[I_FG] + (size_t)i * D * FF, D, FF, w1, 1, 0, gf, scr, gw, ngw, lane);
            cvt_matrix(ap->in[I_FU] + (size_t)i * D * FF, D, FF, w1, 1, 128, gf, scr, gw, ngw, lane);
            cvt_matrix(ap->in[I_FD] + (size_t)i * FF * D, FF, D, w2, 0, 0, nullptr, scr, gw, ngw, lane); }
        for (int m = gw; m < M; m += ngw) { const float* src = m < MP ? ap->in[I_XP] + (size_t)m * D : ap->in[I_XS] + (size_t)(m - MP) * D; float s = 0.f;
#pragma unroll
            for (int j = 0; j < 4; ++j) { const int c = j * 512 + lane * 8; f32x4 v0 = *(const f32x4*)(src + c), v1 = *(const f32x4*)(src + c + 4);
                const u32x4 w = pg8::pack8(v0, v1); *(u32x4*)(XB + (size_t)m * D + c) = w; pg8::unpack8(w, v0, v1);
                s += (v0[0] * v0[0] + v0[1] * v0[1]) + (v0[2] * v0[2] + v0[3] * v0[3]) + (v1[0] * v1[0] + v1[1] * v1[1]) + (v1[2] * v1[2] + v1[3] * v1[3]); }
            s = wave_sum(s); if (m < MP) { if (lane < 8) SSQ[(size_t)m * 8 + lane] = lane == 0 ? s : 0.f; } else SSQS[(size_t)(m - MP) * 64 + lane] = lane == 0 ? s : 0.f; }
        if (bx == 0) {
            for (int c = tid; c < D; c += 512) { const float l0 = ap->in[I_HLB][c], l1 = ap->in[I_HLB][D + c]; CONSTS[c] = 0.f; CONSTS[D + c] = 1.f / (1.f + __expf(l0 - l1)); }
            for (int e = tid; e < 2048; e += 512) { const int hh = e >> 8, idx = e & 255, rel = idx - 192;
                CONSTS[4608 + e] = (ap->in[I_REL][rel_bucket(rel) * 8 + hh] - ap->in[I_REL][15 * 8 + hh]) * (1.0f / ATT_SCALE); }
            if (wave == 0) { float s1 = 0.f, s2 = 0.f;
                for (int c = lane; c < 128; c += 64) { s1 += ap->in[I_LQ1][c] * ap->in[I_LK1][c]; s2 += ap->in[I_LQ2][c] * ap->in[I_LK2][c]; }
                s1 = wave_sum(s1); s2 = wave_sum(s2); if (lane == 0) CONSTS[4096] = __expf(s1) - __expf(s2) + LAMBDA_INIT; }
        }
    }

#pragma unroll 1
    for (int layer = 0; layer < 4; ++layer) {
        const int base = 1 + 10 * layer, mix = layer % 3;
        if (mix == 0) {
            const int j = layer / 3;
#define HG_PTRS PH_PTRS const bf16* whg = (const bf16*)(ws + WS_HG0 + j * HG_STRIDE); const bf16* who = whg + (size_t)NHG * D; \
            float* LOGF = (float*)(ws + WS_A1); bf16* SB = (bf16*)(ws + WS_SB); float* DT = (float*)(ws + WS_DT); (void)whg; (void)who; (void)LOGF; (void)SB; (void)DT;
            if (SITE(1) && PHASE_ON(base + 0)) { PHASE_SYNC(base + 0); HG_PTRS
                pg8::Gemm g{XB, whg, MP, NHG, D, D, D, 0}; pg8::StaticOrder S; S.init(MP, NHG, G, bx);
                pg8::EpiHgrn E{A0, LOGF, A2, A3, ssq_mix, CONSTS + j * D};
                pg8::gemm_phase<pg8::EpiHgrn, pg8::StaticOrder, true, true>(lds, g, S, E);
                sk::SkHgrn ES{A0, LOGF, sq_mix, CONSTS + j * D}; sk::skinny_phase<sk::SkHgrn, 2>(XB + (size_t)MP * D, D, 0, whg, D, D, NHG / 32, vcu, G, ES, (LAS float*)(lds + 131072), lds); }
            if (SITE(2) && PHASE_ON(base + 1)) { PHASE_SYNC(base + 1); HG_PTRS
                for (int it = vcu; it < 256; it += G) { const int h = it & 15, c = it >> 4;
                    hg::hgrn_state_item64(LOGF, A2, c * 1024, 16, h, SB + (size_t)(h * 16 + c) * 16384, DT + (size_t)(h * 16 + c) * 128, ldsg); } }
            if (SITE(3) && PHASE_ON(base + 2)) { PHASE_SYNC(base + 2); HG_PTRS
                for (int e = vcu * 512 + tid; e < 16 * 8192; e += G * 512) { const int h = e >> 13, k = (e & 8191) >> 6, v2 = (e & 63) * 2;
                    f32x2 s = {0.f, 0.f}; bf16* p = SB + ((size_t)h * 16 * 128 + k) * 128 + v2; const float* dp = DT + (size_t)h * 16 * 128 + k;
#pragma unroll 8
                    for (int c = 0; c < 16; ++c) { const unsigned bw = *(const unsigned*)(p + (size_t)c * 16384); const f32x2 bb = {__uint_as_float(bw << 16), __uint_as_float(bw & 0xffff0000u)}; const float d = dp[c * 128];
                        *(unsigned*)(p + (size_t)c * 16384) = cvt_pk_bf16(s[0], s[1]); s = s * d + bb; }
                    *(f32x2*)(out + OFF_HG_P + ((size_t)(j * 16 + h) * 128 + k) * 128 + v2) = s; } }
            if (SITE(4) && PHASE_ON(base + 3)) { PHASE_SYNC(base + 3); HG_PTRS
                const float* gain = ap->in[I_HGAIN] + j * 128;
                for (int it = vcu; it < 256; it += G) { const int h = it & 15, c = it >> 4;
                    hg::hgrn_item<true, true>(A0, LOGF, A2, A3, A4, c * 1024, 64, h, SB + (size_t)(h * 16 + c) * 16384, nullptr, nullptr, gain, ldsg); }
                for (int u = vcu; u < 256; u += G) { const int b = u >> 4, h = u & 15; const size_t so = ((size_t)(j * 16 + b) * 16 + h) * 16384;
                    hg::hgrn_item<true, false>(A0, LOGF, A2, A3, A4, MP + b * 16, 1, h, ap->in[I_SHG] + so, out + OFF_HG_S + so, nullptr, gain, ldsg); } }
            if (SITE(5) && PHASE_ON(base + 4)) { PHASE_SYNC(base + 4); HG_PTRS
                pg8::Gemm g{A4, who, MP, D, D, D, D, 0}; pg8::StaticOrder S; S.init(MP, D, G, bx);
                pg8::EpiResid E{X, XB, ssq_ffn, nullptr, (LAS float*)(lds + 131072)};
                pg8::gemm_phase<pg8::EpiResid, pg8::StaticOrder, true, true>(lds, g, S, E);
                sk::SkResid ES{X, XB, sq_ffn, nullptr}; sk::skinny_phase<sk::SkResid, 1>(A4 + (size_t)MP * D, D, 0, who, D, D, D / 32, vcu, G, ES, (LAS float*)(lds + 131072), lds); }
        } else if (mix == 1) {
            if (SITE(6) && PHASE_ON(base + 0)) { PHASE_SYNC(base + 0); PH_PTRS
                const float* gain = ap->in[I_NMIX] + (size_t)layer * D; const int c4 = tid * 4, grp = tid >> 7;
                for (int t = vcu; t < 256 + 16; t += G) {
                    int xrow0, nt, pos0, hm, npf; const float* hist = nullptr; float* np = nullptr;
                    if (t < 256) { xrow0 = 64 * t; nt = 64; pos0 = 64 * t; hm = t == 0 ? 1 : 0; npf = 49; if (t == 255) np = out + OFF_PL_P; }
                    else { const int b = t - 256; xrow0 = MP + 16 * b; nt = 16; pos0 = 4096; hm = 2; hist = ap->in[I_SPL] + (size_t)b * 15 * D; npf = 1; np = out + OFF_PL_S + (size_t)b * 15 * D; }
                    if (grp == 0) pool_tile<2>(XB, ssq_mix, sq_mix, gain, hist, hm, xrow0, nt, pos0, A0, np, npf, c4);
                    else if (grp == 1) pool_tile<4>(XB, ssq_mix, sq_mix, gain, hist, hm, xrow0, nt, pos0, A0, np, npf, c4);
                    else if (grp == 2) pool_tile<8>(XB, ssq_mix, sq_mix, gain, hist, hm, xrow0, nt, pos0, A0, np, npf, c4);
                    else pool_tile<16>(XB, ssq_mix, sq_mix, gain, hist, hm, xrow0, nt, pos0, A0, np, npf, c4); } }
            if (SITE(7) && PHASE_ON(base + 4)) { PHASE_SYNC(base + 4); PH_PTRS
                pg8::Gemm g{A0, (const bf16*)(ws + WS_WP), MP, D, 512, D, 512, 512}; pg8::StaticOrder S; S.init(MP, D, G, bx);
                pg8::EpiResid E{X, XB, ssq_ffn, ap->in[I_PSC], (LAS float*)(lds + 131072)};
                pg8::gemm_phase<pg8::EpiResid, pg8::StaticOrder, true, true>(lds, g, S, E);
                sk::SkResid ES{X, XB, sq_ffn, ap->in[I_PSC]}; sk::skinny_phase<sk::SkResid, 1>(A0 + (size_t)MP * D, D, 512, (const bf16*)(ws + WS_WP), 512, 512, D / 32, vcu, G, ES, (LAS float*)(lds + 131072), lds); }
        } else {
#define AT_PTRS PH_PTRS bf16* Kb = (bf16*)(ws + WS_A1); bf16* Oat = (bf16*)(ws + WS_A1 + 65 * MiB); float* PART = (float*)(ws + WS_PART); (void)Kb; (void)Oat; (void)PART;
            if (SITE(8) && PHASE_ON(base + 0)) { PHASE_SYNC(base + 0); AT_PTRS
                pg8::Gemm g{XB, (const bf16*)(ws + WS_QKV), MP, NQKV, D, D, D, 0}; pg8::StaticOrder S; S.init(MP, NQKV, G, bx);
                pg8::EpiQkv E{A0, Kb, A2, out, ssq_mix};
                pg8::gemm_phase<pg8::EpiQkv, pg8::StaticOrder, true, true>(lds, g, S, E);
                sk::SkQkv ES{A0, out, sq_mix}; sk::skinny_phase<sk::SkQkv, 2>(XB + (size_t)MP * D, D, 0, (const bf16*)(ws + WS_QKV), D, D, NQKV / 32, vcu, G, ES, (LAS float*)(lds + 131072), lds); }
            if (SITE(9) && PHASE_ON(base + 1)) { PHASE_SYNC(base + 1); AT_PTRS
                float* lut = (float*)(ldsg + 131072); float* scr = (float*)(ldsg + 131072 + 8192);
                for (int e = tid; e < 2048; e += 512) lut[e] = CONSTS[4608 + e];
                __syncthreads();
                if (SITE(15)) for (int u = vcu; u < 256; u += G) { const int b = u >> 4, h = (u >> 1) & 7, sp = u & 1;
                    att::attn_sample_unit(b, h, sp, A0, ap->in[I_CK], ap->in[I_CV], out + OFF_K_S, out + OFF_V_S, PART, lut + h * 256, ldsg, scr); __syncthreads(); }
            }
            if (SITE(9) && SITE(16) && PHASE_ON(base + 1)) { AT_PTRS
                float* lut = (float*)(ldsg + 131072); float* scr = (float*)(ldsg + 131072 + 8192);
                __syncthreads();
                for (int e = tid; e < 2048; e += 512) lut[e] = CONSTS[4608 + e];
                __syncthreads();
                for (int p = vcu; p < 1024; p += G) { const int hc = p >> 6, pr = p & 63, h = hc & 7, c = hc >> 3;
#pragma unroll 1
                    for (int which = 0; which < 2; ++which) { const int qb = which ? pr : 127 - pr;
                        att::attn_unit2(A0 + (size_t)qb * 128 * D + h * 256 + c * 128, Kb + h * 256 + c * 128, A2 + h * 256,
                                        A3 + (size_t)c * M * D + (size_t)qb * 128 * D + h * 256, 2 * qb + 2, 2 * qb + ((wave & 3) >> 1), 128 * qb + 32 * (wave & 3), lut + h * 256, ldsg, scr);
                        __syncthreads(); } } }
            if (SITE(10) && PHASE_ON(base + 2)) { PHASE_SYNC(base + 2); AT_PTRS
                const float lam = CONSTS[4096]; const f32x4 sg = *(const f32x4*)(ap->in[I_SUBG] + lane * 4);
                {
                    const f32x4 g0 = *(const f32x4*)(ap->in[I_SUBG] + (lane & 31) * 8), g1 = *(const f32x4*)(ap->in[I_SUBG] + (lane & 31) * 8 + 4);
                    for (int row = gw; row < MP; row += ngw) { const size_t off = (size_t)row * D + lane * 8; u32x4 wa[4], wb[4];
#pragma unroll
                        for (int q = 0; q < 4; ++q) { wa[q] = *(const u32x4*)(A3 + off + q * 512); wb[q] = *(const u32x4*)(A3 + (size_t)M * D + off + q * 512); }
#pragma unroll
                        for (int q = 0; q < 4; ++q) { f32x4 a0, a1, b0, b1; pg8::unpack8(wa[q], a0, a1); pg8::unpack8(wb[q], b0, b1);
                            a0 = a0 - b0 * lam; a1 = a1 - b1 * lam;
                            float ss = (a0[0] * a0[0] + a0[1] * a0[1]) + (a0[2] * a0[2] + a0[3] * a0[3]) + (a1[0] * a1[0] + a1[1] * a1[1]) + (a1[2] * a1[2] + a1[3] * a1[3]);
                            ss = row16_sum(ss); ss += __shfl_xor(ss, 16);
                            const float rs = __builtin_amdgcn_rsqf(ss * (1.f / 256.f) + EPS) * (1.f - LAMBDA_INIT);
                            *(u32x4*)(Oat + off + q * 512) = pg8::pack8(a0 * rs * g0, a1 * rs * g1); } } }
                for (int it = MP * 8 + gw; it < M * 8; it += ngw) { const int row = it >> 3, h = it & 7; f32x4 o;
                    if (row < MP) { const size_t off = (size_t)row * D + h * 256 + lane * 4; const u32x2 w0 = *(const u32x2*)(A3 + off), w1 = *(const u32x2*)(A3 + (size_t)M * D + off);
                        o[0] = __uint_as_float(w0.x << 16) - lam * __uint_as_float(w1.x << 16); o[1] = __uint_as_float(w0.x & 0xffff0000u) - lam * __uint_as_float(w1.x & 0xffff0000u);
                        o[2] = __uint_as_float(w0.y << 16) - lam * __uint_as_float(w1.y << 16); o[3] = __uint_as_float(w0.y & 0xffff0000u) - lam * __uint_as_float(w1.y & 0xffff0000u);
                    } else { const int b = (row - MP) >> 4, t = (row - MP) & 15, vhalf = lane >> 5, col = (lane & 31) * 4; f32x4 oc[2];
#pragma unroll
                        for (int c = 0; c < 2; ++c) { const float* p0 = PART + (size_t)((((b * 8 + h) * 2 + 0) * 4) + c * 2 + vhalf) * 2112; const float* p1 = p0 + 4 * 2112;
                            const float m0 = p0[t], m1 = p1[t], l0 = p0[16 + t], l1 = p1[16 + t], mm = fmaxf(m0, m1);
                            const float w0 = __builtin_amdgcn_exp2f((m0 - mm) * (ATT_SCALE * 1.4426950408889634f)), w1 = __builtin_amdgcn_exp2f((m1 - mm) * (ATT_SCALE * 1.4426950408889634f));
                            const f32x4 o0 = *(const f32x4*)(p0 + 64 + t * 128 + col), o1 = *(const f32x4*)(p1 + 64 + t * 128 + col);
                            oc[c] = (o0 * w0 + o1 * w1) * (1.0f / (l0 * w0 + l1 * w1)); }
                        o = oc[0] - oc[1] * lam; }
                    const float ss = wave_sum((o[0] * o[0] + o[1] * o[1]) + (o[2] * o[2] + o[3] * o[3]));
                    const float rs = __builtin_amdgcn_rsqf(ss * (1.f / 256.f) + EPS) * (1.f - LAMBDA_INIT);
                    o = o * rs * sg; u32x2 w; w.x = cvt_pk_bf16(o[0], o[1]); w.y = cvt_pk_bf16(o[2], o[3]);
                    *(u32x2*)(Oat + (size_t)row * D + h * 256 + lane * 4) = w; } }
            if (SITE(11) && PHASE_ON(base + 4)) { PHASE_SYNC(base + 4); AT_PTRS
                pg8::Gemm g{Oat, (const bf16*)(ws + WS_WOA), MP, D, D, D, D, 0}; pg8::StaticOrder S; S.init(MP, D, G, bx);
                pg8::EpiResid E{X, XB, ssq_ffn, nullptr, (LAS float*)(lds + 131072)};
                pg8::gemm_phase<pg8::EpiResid, pg8::StaticOrder, true, true>(lds, g, S, E);
                sk::SkResid ES{X, XB, sq_ffn, nullptr}; sk::skinny_phase<sk::SkResid, 1>(Oat + (size_t)MP * D, D, 0, (const bf16*)(ws + WS_WOA), D, D, D / 32, vcu, G, ES, (LAS float*)(lds + 131072), lds); }
        }
        if (SITE(12) && PHASE_ON(base + 5)) { PHASE_SYNC(base + 5); PH_PTRS
            const bf16* w1 = (const bf16*)(ws + WS_W1 + layer * FFN_STRIDE); pg8::Gemm g{XB, w1, MP, 2 * FF, D, D, D, 0}; pg8::StaticOrder S; S.init(MP, 2 * FF, G, bx);
            pg8::EpiFfn1 E{A0, ssq_ffn};
            pg8::gemm_phase<pg8::EpiFfn1, pg8::StaticOrder, true, true>(lds, g, S, E);
            sk::SkFfn1 ES{A0, sq_ffn}; sk::skinny_phase<sk::SkFfn1, 2>(XB + (size_t)MP * D, D, 0, w1, D, D, FF / 16, vcu, G, ES, (LAS float*)(lds + 131072), lds); }
        if (SITE(13) && PHASE_ON(base + 6)) { PHASE_SYNC(base + 6); PH_PTRS
            const bf16* w2 = (const bf16*)(ws + WS_W1 + layer * FFN_STRIDE + W2_OFF); pg8::Gemm g{A0, w2, MP, D, FF, FF, FF, 0}; pg8::StaticOrder S; S.init(MP, D, G, bx, 1);
            pg8::EpiResid E{X, XB, ssq_next, nullptr, (LAS float*)(lds + 131072)};
            pg8::gemm_phase<pg8::EpiResid, pg8::StaticOrder, true, true>(lds, g, S, E);
            sk::SkResid ES{X, XB, sq_next, nullptr}; sk::skinny_phase<sk::SkResid, 1>(A0 + (size_t)MP * FF, FF, 0, w2, FF, FF, D / 32, vcu, G, ES, (LAS float*)(lds + 131072), lds); }
    }
    if (SITE(14) && PHASE_ON(41)) { const int layer = 0;
        PHASE_SYNC(41); PH_PTRS
        const float* ssq = SSQ + (size_t)8 * M * 8; const float* gf = ap->in[I_NFIN];
        for (int m = gw; m < M; m += ngw) { const float rs = row_scale_any(ssq, SSQS + (size_t)8 * 16384, m); float* dst = m < MP ? out + OFF_Y_P + (size_t)m * D : out + OFF_Y_S + (size_t)(m - MP) * D;
#pragma unroll
            for (int j = 0; j < 8; ++j) { const int c = j * 256 + lane * 4; *(f32x4*)(dst + c) = ldx4(XB + (size_t)m * D + c) * rs * *(const f32x4*)(gf + c); } } }
}

extern "C" void kernel_launch(void* const* d_in, const int* in_sizes, int n_in, void* d_out, int out_size, void* d_ws, size_t ws_size, hipStream_t stream) {
    static int grid = 0;
    if (grid == 0) {
        if (n_in != 31 || (size_t)out_size != OUT_END || ws_size < WS_END) { fprintf(stderr, "kernel_launch: unexpected shapes: n_in %d out %d ws %zu\n", n_in, out_size, ws_size); grid = -1; return; }
        int dev = 0, cus = 0, per_cu = 0;
        if (hipGetDevice(&dev) != hipSuccess || hipDeviceGetAttribute(&cus, hipDeviceAttributeMultiprocessorCount, dev) != hipSuccess) { grid = -1; return; }
        if (hipFuncSetAttribute((const void*)fwd_kernel, hipFuncAttributeMaxDynamicSharedMemorySize, LDS_BYTES) != hipSuccess) { fprintf(stderr, "kernel_launch: hipFuncSetAttribute failed\n"); grid = -1; return; }
        if (hipOccupancyMaxActiveBlocksPerMultiprocessor(&per_cu, (const void*)fwd_kernel, 512, LDS_BYTES) != hipSuccess || per_cu < 1) { fprintf(stderr, "kernel_launch: occupancy query says %d\n", per_cu); (void)hipGetLastError(); per_cu = 1; }
        grid = cus;
    }
    if (grid < 0) return;
    (void)hipMemsetAsync((char*)d_ws + WS_CTL, 0, CTL_ZERO_BYTES, stream);
    Args a{};
    for (int i = 0; i < 31; ++i) a.in[i] = (const float*)d_in[i];
    a.out = (float*)d_out; a.ws = (unsigned char*)d_ws;
#if MK_ONE_LAUNCH
    a.lo = 0; a.hi = PH_END;
    hipLaunchKernelGGL(fwd_kernel, dim3(grid), dim3(512), LDS_BYTES, stream, a);
#else
    static const int ids[] = {0, 1, 2, 3, 4, 5, 6, 7, 11, 15, 16, 17, 21, 22, 23, 25, 26, 27, 31, 32, 33, 34, 35, 36, 37, 41};
    for (int k = 0; k < (int)(sizeof(ids) / sizeof(ids[0])); ++k) { a.lo = ids[k]; a.hi = ids[k] + 1; hipLaunchKernelGGL(fwd_kernel, dim3(grid), dim3(512), LDS_BYTES, stream, a); }
#endif
    const hipError_t le = hipPeekAtLastError();
    if (le != hipSuccess) fprintf(stderr, "kernel_launch: launch failed: %s\n", hipGetErrorName(le));
}
```
